# Optimizing an MI355X kernel written in HIP

```python
import jax
import jax.numpy as jnp
from jax import lax
import numpy as np

D_MODEL = 1024
BATCH = 8
SEQ = 2048
DEPTH = 2

CTX_LEN = 256
GRID_W = 64
EPS = 1e-6
ALPHA = (2 * DEPTH) ** 0.25
BETA = (8 * DEPTH) ** -0.25
N_MOD = 6

CONV_CH = D_MODEL // 2
CONV_WIDTH = 31
ATT_HEADS = 8
ATT_KV_HEADS = 2
HEAD_DIM = 64
ATT_W = ATT_HEADS * HEAD_DIM
KV_W = ATT_KV_HEADS * HEAD_DIM
Q_BLOCK = 128
ROPE_BASE = 10000.0
AB_IN = 2 * CONV_CH + ATT_W + 2 * KV_W
AB_OUT = CONV_CH + ATT_W

ML_HEADS = 4
ML_DQK = D_MODEL // 8
ML_DV = D_MODEL // 4
ML_CHUNK = 64
ML_QK_W = ML_HEADS * ML_DQK
ML_V_W = ML_HEADS * ML_DV
C_IN = 2 * ML_QK_W + 2 * ML_V_W + 4 * ML_HEADS
C_OUT = ML_V_W

PEER_HEADS = 8
PEER_DK = 256
N_KEYS = 128
N_EXPERTS = N_KEYS * N_KEYS
PEER_TOPK = 16
PEER_BLOCK = 128

N_EVEN = (DEPTH + 1) // 2
N_ODD = DEPTH // 2

kernel_name = 'hybrid_conv_gqa_mlstm_peer_diffusion_block'


def layer_norm(x, g=None, b=None):
    xf = x.astype(jnp.float32)
    mu = jnp.mean(xf, axis=-1, keepdims=True)
    var = jnp.mean(jnp.square(xf - mu), axis=-1, keepdims=True)
    y = (xf - mu) * lax.rsqrt(var + EPS)
    if g is not None:
        y = y * g.astype(jnp.float32)
    if b is not None:
        y = y + b.astype(jnp.float32)
    return y.astype(x.dtype)


def rms_norm(x, g):
    xf = x.astype(jnp.float32)
    y = xf * lax.rsqrt(jnp.mean(jnp.square(xf), axis=-1, keepdims=True) + EPS)
    return (y * g.astype(jnp.float32)).astype(x.dtype)


def modulate(x, shift, scale):
    return layer_norm(x) * (1 + scale) + shift


def rope_1d(x, pos):
    f = x.shape[-1] // 2
    inv_freq = ROPE_BASE ** (-jnp.arange(f, dtype=jnp.float32) / f)
    ang = pos[:, None] * inv_freq[None, :]
    cos = jnp.cos(ang)[None, :, None, :]
    sin = jnp.sin(ang)[None, :, None, :]
    xf = x.astype(jnp.float32)
    x1, x2 = xf[..., :f], xf[..., f:]
    return jnp.concatenate([x1 * cos - x2 * sin, x2 * cos + x1 * sin], axis=-1).astype(x.dtype)


def axial_rope(x, row, col):
    half = x.shape[-1] // 2
    return jnp.concatenate([rope_1d(x[..., :half], row), rope_1d(x[..., half:], col)], axis=-1)


def grid_positions(n_tokens):
    rows = n_tokens // GRID_W
    row = jnp.repeat(jnp.arange(rows, dtype=jnp.float32), GRID_W)
    col = jnp.tile(jnp.arange(GRID_W, dtype=jnp.float32), rows)
    return row, col


def depthwise_conv(x, w, b):
    pad = CONV_WIDTH // 2
    y = lax.conv_general_dilated(x, w[:, None, :].astype(x.dtype), window_strides=(1,),
                                 padding=[(pad, pad)], dimension_numbers=('NWC', 'WIO', 'NWC'),
                                 feature_group_count=x.shape[-1])
    return y + b


def gqa_attend(q, k, v):
    s = jnp.einsum('bqkgd,bskd->bkgqs', q, k).astype(jnp.float32)
    p = jax.nn.softmax(s, axis=-1).astype(v.dtype)
    return jnp.einsum('bkgqs,bskd->bqkgd', p, v)


def mixer_conv_gqa(hc, hl, w_in, b_in, conv_w, conv_b, conv_ln_g, conv_ln_b, q_norm_g, k_norm_g,
                   w_out, b_out, need_ctx):
    B, L, _ = hl.shape
    Lc = hc.shape[1]
    G = ATT_HEADS // ATT_KV_HEADS
    cuts = [CONV_CH, 2 * CONV_CH, 2 * CONV_CH + ATT_W, 2 * CONV_CH + ATT_W + KV_W]

    def project(h):
        n = h.shape[1]
        a_val, a_gate, q, k, v = jnp.split(h @ w_in + b_in, cuts, axis=-1)
        q = rms_norm(q.reshape(B, n, ATT_HEADS, HEAD_DIM), q_norm_g)
        k = rms_norm(k.reshape(B, n, ATT_KV_HEADS, HEAD_DIM), k_norm_g)
        v = v.reshape(B, n, ATT_KV_HEADS, HEAD_DIM)
        return a_val, a_gate, q, k, v

    def conv_group(a_val, a_gate):
        u = depthwise_conv(a_val * jax.nn.sigmoid(a_gate), conv_w, conv_b)
        return jax.nn.silu(layer_norm(u, conv_ln_g, conv_ln_b))

    def merge(conv_out, att_out):
        return jnp.concatenate([conv_out, att_out], axis=-1) @ w_out + b_out

    ac_v, ac_g, qc, kc, vc = project(hc)
    al_v, al_g, ql, kl, vl = project(hl)
    row, col = grid_positions(L)
    ql = axial_rope(ql, row, col)
    kl = axial_rope(kl, row, col)
    scale = HEAD_DIM ** -0.5
    k_all = jnp.concatenate([kc, kl], axis=1)
    v_all = jnp.concatenate([vc, vl], axis=1)
    q_blocks = (ql * scale).reshape(B, L // Q_BLOCK, Q_BLOCK, ATT_KV_HEADS, G, HEAD_DIM).transpose(1, 0, 2, 3, 4, 5)
    o_blocks = lax.map(lambda qb: gqa_attend(qb, k_all, v_all), q_blocks)
    ol = o_blocks.transpose(1, 0, 2, 3, 4, 5).reshape(B, L, ATT_W)
    yl = merge(conv_group(al_v, al_g), ol)
    yc = None
    if need_ctx:
        oc = gqa_attend((qc * scale).reshape(B, Lc, ATT_KV_HEADS, G, HEAD_DIM), kc, vc).reshape(B, Lc, ATT_W)
        yc = merge(conv_group(ac_v, ac_g), oc)
    return yc, yl


def mlstm_scan(q, k, v, ig, lf, state):
    B, L = q.shape[:2]
    nc = L // ML_CHUNK

    def chunks(t):
        t = t.reshape((B, nc, ML_CHUNK) + t.shape[2:])
        return jnp.moveaxis(jnp.moveaxis(t, 1, 0), 3, 2)

    mask = jnp.tril(jnp.ones((ML_CHUNK, ML_CHUNK), dtype=bool))

    def step(carry, inp):
        C, n, m = carry
        qc, kc, vc, ic, fc = inp
        b = jnp.cumsum(fc, axis=-1)
        a = b + m[..., None]
        dlog = jnp.where(mask, b[..., :, None] - b[..., None, :] + ic[..., None, :], -jnp.inf)
        mt = jnp.maximum(a, jnp.max(dlog, axis=-1))
        w = jnp.exp(dlog - mt[..., None])
        aw = jnp.exp(a - mt)
        s = jnp.einsum('bhtd,bhsd->bhts', qc, kc) * w
        num = jnp.einsum('bhts,bhsv->bhtv', s, vc) + aw[..., None] * jnp.einsum('bhtd,bhvd->bhtv', qc, C)
        den = jnp.sum(s, axis=-1) + aw * jnp.einsum('bhtd,bhd->bht', qc, n)
        h = num / jnp.maximum(jnp.abs(den), jnp.exp(-mt))[..., None]
        bl = b[..., -1]
        wl = bl[..., None] - b + ic
        mn = jnp.maximum(bl + m, jnp.max(wl, axis=-1))
        wc = jnp.exp(wl - mn[..., None])
        dc = jnp.exp(bl + m - mn)
        C = dc[..., None, None] * C + jnp.einsum('bhs,bhsv,bhsd->bhvd', wc, vc, kc)
        n = dc[..., None] * n + jnp.einsum('bhs,bhsd->bhd', wc, kc)
        return (C, n, mn), h

    state, h = lax.scan(step, state, (chunks(q), chunks(k), chunks(v), chunks(ig), chunks(lf)))
    h = jnp.swapaxes(jnp.moveaxis(h, 0, 1), 2, 3).reshape(B, L, ML_HEADS, ML_DV)
    return state, h


def mixer_mlstm(hc, hl, w_in, b_in, norm_g, w_out, b_out, need_ctx):
    B = hl.shape[0]
    cuts = [ML_QK_W, 2 * ML_QK_W, 2 * ML_QK_W + ML_V_W, 2 * ML_QK_W + 2 * ML_V_W]
    f32 = jnp.float32

    def project(h):
        n = h.shape[1]
        q, k, v, o, g = jnp.split(h @ w_in + b_in, cuts, axis=-1)
        q = q.reshape(B, n, ML_HEADS, ML_DQK).astype(f32)
        k = k.reshape(B, n, ML_HEADS, ML_DQK).astype(f32) * (ML_DQK ** -0.5)
        v = v.reshape(B, n, ML_HEADS, ML_DV).astype(f32)
        g = g.reshape(B, n, 4, ML_HEADS).astype(f32)
        fwd = (g[:, :, 0], jax.nn.log_sigmoid(g[:, :, 1]))
        bwd = (g[:, :, 2], jax.nn.log_sigmoid(g[:, :, 3]))
        return q, k, v, o, fwd, bwd

    def flip(t):
        return jnp.flip(t, axis=1)

    qc, kc, vc, oc, gc_f, gc_b = project(hc)
    ql, kl, vl, ol, gl_f, gl_b = project(hl)
    init = (jnp.zeros((B, ML_HEADS, ML_DV, ML_DQK), f32), jnp.zeros((B, ML_HEADS, ML_DQK), f32),
            jnp.zeros((B, ML_HEADS), f32))
    st_cf, h_cf = mlstm_scan(qc, kc, vc, gc_f[0], gc_f[1], init)
    _, h_lf = mlstm_scan(ql, kl, vl, gl_f[0], gl_f[1], st_cf)
    st_cb, h_cb = mlstm_scan(flip(qc), flip(kc), flip(vc), flip(gc_b[0]), flip(gc_b[1]), init)
    _, h_lb = mlstm_scan(flip(ql), flip(kl), flip(vl), flip(gl_b[0]), flip(gl_b[1]), st_cb)

    def finish(hf, hb, o):
        n = o.shape[1]
        hn = layer_norm(hf + hb, norm_g.reshape(ML_HEADS, ML_DV))
        y = hn.reshape(B, n, C_OUT).astype(o.dtype) * jax.nn.sigmoid(o)
        return y @ w_out + b_out

    yl = finish(h_lf, flip(h_lb), ol)
    yc = finish(h_cf, flip(h_cb), oc) if need_ctx else None
    return yc, yl


def peer(h, w_q, sub_k1, sub_k2, u_tab, v_tab):
    B, L, D = h.shape
    xt = h.reshape(B * L // PEER_BLOCK, PEER_BLOCK, D)

    def block(xb):
        qh = (xb @ w_q).reshape(PEER_BLOCK, PEER_HEADS, 2, PEER_DK // 2)
        s1 = jnp.einsum('thd,hkd->thk', qh[:, :, 0], sub_k1).astype(jnp.float32)
        s2 = jnp.einsum('thd,hkd->thk', qh[:, :, 1], sub_k2).astype(jnp.float32)
        v1, i1 = lax.top_k(s1, PEER_TOPK)
        v2, i2 = lax.top_k(s2, PEER_TOPK)
        cand = (v1[..., :, None] + v2[..., None, :]).reshape(PEER_BLOCK, PEER_HEADS, PEER_TOPK * PEER_TOPK)
        cid = (i1[..., :, None] * N_KEYS + i2[..., None, :]).reshape(PEER_BLOCK, PEER_HEADS, PEER_TOPK * PEER_TOPK)
        sc, pos = lax.top_k(cand, PEER_TOPK)
        eid = jnp.take_along_axis(cid, pos, axis=-1)
        g = jax.nn.softmax(sc, axis=-1)
        act = jax.nn.gelu(jnp.einsum('thed,td->the', u_tab[eid], xb).astype(jnp.float32), approximate=False)
        return jnp.einsum('the,thed->td', (g * act).astype(xb.dtype), v_tab[eid])

    return lax.map(block, xt).reshape(B, L, D)


def setup_inputs(seed: int = 0) -> dict:
    key = jax.random.key(seed)
    keys = iter(list(jax.random.split(key, 40)))

    def nrm(shape, s):
        return jax.random.normal(next(keys), shape, jnp.float32) * s

    D = D_MODEL
    g0 = C_IN - 4 * ML_HEADS
    forget_bias = jnp.linspace(3.0, 6.0, ML_HEADS, dtype=jnp.float32)
    ml_b_in = nrm((N_ODD, C_IN), 0.02)
    ml_b_in = ml_b_in.at[:, g0 + ML_HEADS:g0 + 2 * ML_HEADS].add(forget_bias).at[:, g0 + 3 * ML_HEADS:].add(forget_bias)
    return {
        'x': nrm((BATCH, SEQ, D), 1.0),
        'c': nrm((BATCH, D), 1.0),
        'ctx': nrm((BATCH, CTX_LEN, D), 1.0),
        'c_ctx': nrm((D,), 1.0),
        'w_mod': nrm((DEPTH, D, N_MOD * D), D ** -0.5),
        'b_mod': nrm((DEPTH, N_MOD * D), 0.02),
        'ln1_g': 1.0 + nrm((DEPTH, D), 0.02),
        'ln1_b': nrm((DEPTH, D), 0.02),
        'ln2_g': 1.0 + nrm((DEPTH, D), 0.02),
        'ln2_b': nrm((DEPTH, D), 0.02),
        'ab_w_in': nrm((N_EVEN, D, AB_IN), D ** -0.5),
        'ab_b_in': nrm((N_EVEN, AB_IN), 0.02),
        'ab_conv_w': nrm((N_EVEN, CONV_WIDTH, CONV_CH), CONV_WIDTH ** -0.5),
        'ab_conv_b': nrm((N_EVEN, CONV_CH), 0.02),
        'ab_conv_ln_g': 1.0 + nrm((N_EVEN, CONV_CH), 0.02),
        'ab_conv_ln_b': nrm((N_EVEN, CONV_CH), 0.02),
        'ab_q_norm_g': 1.0 + nrm((N_EVEN, HEAD_DIM), 0.02),
        'ab_k_norm_g': 1.0 + nrm((N_EVEN, HEAD_DIM), 0.02),
        'ab_w_out': nrm((N_EVEN, AB_OUT, D), BETA * AB_OUT ** -0.5),
        'ab_b_out': nrm((N_EVEN, D), 0.02),
        'ml_w_in': nrm((N_ODD, D, C_IN), D ** -0.5),
        'ml_b_in': ml_b_in,
        'ml_norm_g': 1.0 + nrm((N_ODD, C_OUT), 0.02),
        'ml_w_out': nrm((N_ODD, C_OUT, D), BETA * C_OUT ** -0.5),
        'ml_b_out': nrm((N_ODD, D), 0.02),
        'peer_w_q': nrm((DEPTH, D, PEER_HEADS * PEER_DK), D ** -0.5),
        'peer_k1': nrm((DEPTH, PEER_HEADS, N_KEYS, PEER_DK // 2), (PEER_DK // 2) ** -0.5),
        'peer_k2': nrm((DEPTH, PEER_HEADS, N_KEYS, PEER_DK // 2), (PEER_DK // 2) ** -0.5),
        'peer_u': nrm((DEPTH, N_EXPERTS, D), D ** -0.5),
        'peer_v': nrm((DEPTH, N_EXPERTS, D), BETA),
    }


def reference(x, c, ctx, c_ctx, w_mod, b_mod, ln1_g, ln1_b, ln2_g, ln2_b,
              ab_w_in, ab_b_in, ab_conv_w, ab_conv_b, ab_conv_ln_g, ab_conv_ln_b, ab_q_norm_g, ab_k_norm_g,
              ab_w_out, ab_b_out, ml_w_in, ml_b_in, ml_norm_g, ml_w_out, ml_b_out,
              peer_w_q, peer_k1, peer_k2, peer_u, peer_v):
    for i in range(DEPTH):
        need_ctx = i < DEPTH - 1
        j = i // 2
        mod_l = (jax.nn.silu(c) @ w_mod[i] + b_mod[i])[:, None, :]
        mod_c = (jax.nn.silu(c_ctx) @ w_mod[i] + b_mod[i])[None, None, :]
        sh1l, sc1l, g1l, sh2l, sc2l, g2l = jnp.split(mod_l, N_MOD, axis=-1)
        sh1c, sc1c, g1c, sh2c, sc2c, g2c = jnp.split(mod_c, N_MOD, axis=-1)
        hl = modulate(x, sh1l, sc1l)
        hc = modulate(ctx, sh1c, sc1c)
        if i % 2 == 0:
            yc, yl = mixer_conv_gqa(hc, hl, ab_w_in[j], ab_b_in[j], ab_conv_w[j], ab_conv_b[j],
                                    ab_conv_ln_g[j], ab_conv_ln_b[j], ab_q_norm_g[j], ab_k_norm_g[j],
                                    ab_w_out[j], ab_b_out[j], need_ctx)
        else:
            yc, yl = mixer_mlstm(hc, hl, ml_w_in[j], ml_b_in[j], ml_norm_g[j], ml_w_out[j], ml_b_out[j], need_ctx)
        x = layer_norm(ALPHA * x + g1l * yl, ln1_g[i], ln1_b[i])
        x = layer_norm(ALPHA * x + g2l * peer(modulate(x, sh2l, sc2l), peer_w_q[i], peer_k1[i], peer_k2[i],
                                              peer_u[i], peer_v[i]), ln2_g[i], ln2_b[i])
        if need_ctx:
            ctx = layer_norm(ALPHA * ctx + g1c * yc, ln1_g[i], ln1_b[i])
            ctx = layer_norm(ALPHA * ctx + g2c * peer(modulate(ctx, sh2c, sc2c), peer_w_q[i], peer_k1[i],
                                                      peer_k2[i], peer_u[i], peer_v[i]), ln2_g[i], ln2_b[i])
    return x
```

```cpp
#define MK_ALL 1
#include <hip/hip_runtime.h>
#include <cstdio>
#include <cstdint>
#include <cmath>

typedef unsigned short bf16_t;

constexpr int D = 1024, NB = 8, SEQ = 2048, CTX = 256;
constexpr int TL = NB * SEQ;
constexpr int TC = NB * CTX;
constexpr int TT = TL + TC;
constexpr int NMOD = 6 * D;
constexpr int KVLEN = CTX + SEQ;
constexpr int AB_IN = 1792, C_IN = 3088;
constexpr float EPS = 1e-6f;
constexpr float ALPHA = 1.4142135623730951f;
constexpr float QSCALE = 0.125f * 1.4426950408889634f;

constexpr size_t MiB = 1u << 20;
constexpr size_t WS_MOD  = 0;
constexpr size_t WS_GATE = 1 * MiB;
constexpr size_t WS_XC   = 3 * MiB;
constexpr size_t WS_HBF  = 11 * MiB;
constexpr size_t WS_YBF  = 47 * MiB;
constexpr size_t WS_EID  = 83 * MiB;
constexpr size_t WS_GW   = 92 * MiB;
constexpr size_t WS_C    = 101 * MiB;
constexpr size_t WS_GLU  = WS_C;
constexpr size_t WS_Q    = WS_C + 18 * MiB;
constexpr size_t WS_K    = WS_C + 36 * MiB;
constexpr size_t WS_V    = WS_C + 41 * MiB;
constexpr size_t WS_QM   = WS_C;
constexpr size_t WS_KM   = WS_C + 18 * MiB;
constexpr size_t WS_VM   = WS_C + 36 * MiB;
constexpr size_t WS_OM   = WS_C + 72 * MiB;
constexpr size_t WS_QP   = WS_C;
constexpr size_t WS_NP   = 209 * MiB;
constexpr size_t WS_END  = 245 * MiB;

__device__ __forceinline__ float bf2f(bf16_t v) { return __uint_as_float(((unsigned)v) << 16); }
__device__ __forceinline__ bf16_t f2bf(float f) { unsigned u = __float_as_uint(f); return (bf16_t)((u + 0x7fffu + ((u >> 16) & 1u)) >> 16); }
__device__ __forceinline__ float wave_sum(float v) {
#pragma unroll
    for (int o = 1; o < 64; o <<= 1) v += __shfl_xor(v, o);
    return v;
}
__device__ __forceinline__ float wave_max(float v) {
#pragma unroll
    for (int o = 1; o < 64; o <<= 1) v = fmaxf(v, __shfl_xor(v, o));
    return v;
}
__device__ __forceinline__ int mod_row(int r) { return r < TL ? r / SEQ : NB; }
__device__ __forceinline__ int kv_row(int r) { return r < TL ? (r / SEQ) * KVLEN + CTX + (r % SEQ) : ((r - TL) / CTX) * KVLEN + ((r - TL) % CTX); }
__device__ __forceinline__ float block_sum256(float v, float* red) {
    v = wave_sum(v);
    __syncthreads();
    if ((threadIdx.x & 63) == 0) red[threadIdx.x >> 6] = v;
    __syncthreads();
    return red[0] + red[1] + red[2] + red[3];
}

__device__ __forceinline__ int fresh_lane() { int l; asm volatile("v_mbcnt_lo_u32_b32 %0, -1, 0\n\tv_mbcnt_hi_u32_b32 %0, -1, %0" : "=v"(l)); return l; }
template <int M> __device__ __forceinline__ float xshfl(float v) {
    if constexpr (M < 32) return __int_as_float(__builtin_amdgcn_ds_swizzle(__float_as_int(v), 0x1F | (M << 10)));
    else { const auto rr = __builtin_amdgcn_permlane32_swap(__float_as_uint(v), __float_as_uint(v), false, false);
           return (__builtin_amdgcn_mbcnt_hi(~0u, __builtin_amdgcn_mbcnt_lo(~0u, 0u)) < 32u) ? __uint_as_float(rr[1]) : __uint_as_float(rr[0]); }
}
namespace pg8 {
#define PG8_LAS __attribute__((address_space(3)))
typedef unsigned short bf16_t;
typedef short bf16x8 __attribute__((ext_vector_type(8)));
typedef float f32x4 __attribute__((ext_vector_type(4)));
typedef unsigned u32x4 __attribute__((ext_vector_type(4)));
constexpr int BM = 256, BK = 64, HALF = 128, HTB = HALF * BK * 2  , STAGE_BYTES = 8 * HTB, NXCD = 8, WGM = 8;

__host__ __device__ __forceinline__ int lds_byte(int r, int c) { const int st = (r >> 4) * 2 + (c >> 5), rr = r & 15, cc = c & 31, ob = rr * 64 + cc * 2; return st * 1024 + (ob ^ (((ob >> 9) & 1) << 5)); }
__host__ __device__ __forceinline__ void stage_rc(int b, int& R, int& C) { const int st = b / 1024, sb = b % 1024, swz = sb ^ (((sb >> 9) & 1) << 5); R = (st >> 1) * 16 + swz / 64; C = (st & 1) * 32 + (swz % 64) / 2; }
__host__ __device__ __forceinline__ int perm32(int rho) { const int n = rho >> 4, i = rho & 15; return 8 * (i >> 2) + 4 * n + (i & 3); }

struct Unit { int pm, pn; };
struct Gemm { const bf16_t* A; const bf16_t* Bt; int M, N, K; };

struct StaticOrder {
    int nM, nN, nwg, G, c;
    __host__ __device__ void init(int M, int N, int G_, int c_) { nM = M / BM; nN = N / BM; nwg = nM * nN; G = G_; c = c_; }
    __host__ __device__ bool next(int i, Unit& u) const {
        const long L = (long)i * G + c; if (L >= nwg) return false;
        int wgid = (int)L; { const int q = nwg / NXCD, r = nwg % NXCD, xcd = wgid % NXCD, off = wgid / NXCD; wgid = (xcd < r ? xcd * (q + 1) : r * (q + 1) + (xcd - r) * q) + off; }
        const int nig = WGM * nN, gid = wgid / nig, fm = gid * WGM, gsz = (nM - fm) < WGM ? (nM - fm) : WGM;
        u.pm = fm + ((wgid % nig) % gsz); u.pn = (wgid % nig) / gsz; return true;
    }
    __device__ __forceinline__ void a_ready(const Unit&) const {}
    __device__ __forceinline__ void done(const Unit&) const {}
};
__device__ __forceinline__ unsigned cvt_pk_bf16(float lo, float hi) { unsigned r; asm volatile("v_cvt_pk_bf16_f32 %0, %1, %2" : "=v"(r) : "v"(lo), "v"(hi)); return r; }
template <class Epi, class Sched, bool ALIGN_EPI = false, bool SP2 = false>
__device__ __forceinline__ void gemm_phase(PG8_LAS unsigned char* lds, const Gemm g, const Sched& S, const Epi& E, const int wid) {
    const int lane = fresh_lane(), tid = wid * 64 + lane, wr = wid >> 2, wc = wid & 3, fr = lane & 15, fq = lane >> 4;
    const int K = g.K, nt = K / BK;
    unsigned voffA[2], voffB[2];
#pragma unroll
    for (int i = 0; i < 2; ++i) { int R, C; stage_rc(tid * 16 + i * 8192, R, C); const int Rb = Epi::PERM ? ((R & ~31) + perm32(R & 31)) : R;
        voffA[i] = (unsigned)(R * K + C) * 2u; voffB[i] = (unsigned)(Rb * K + C) * 2u; }
    const size_t kstep = (size_t)(BK * 2);
    const size_t hstep = (size_t)HALF * K * 2;
    const size_t tstep = 2 * hstep;
    const unsigned ldsw = (unsigned)wid * 1024u;
    const int aoff = lds_byte(wr * 64 + fr, fq * 8), boff = lds_byte(wc * 32 + fr, fq * 8);
#define PG8_SA(b, h) (((b) * 2 + (h)) * HTB)
#define PG8_SB(b, h) ((4 + (b) * 2 + (h)) * HTB)
#define PG8_STAGE(bufoff, gbase, voff) do { _Pragma("unroll") for (int _i = 0; _i < 2; ++_i) \
        __builtin_amdgcn_global_load_lds((const unsigned*)((const char*)(gbase) + (voff)[_i]), (PG8_LAS unsigned*)(lds + (bufoff) + ldsw + _i * 8192), 16, 0, 0); } while (0)
#define PG8_LDA(dst, b, h) do { _Pragma("unroll") for (int m = 0; m < 4; ++m) _Pragma("unroll") for (int k = 0; k < 2; ++k) dst[m][k] = *(const PG8_LAS bf16x8*)(lds + PG8_SA(b, h) + aoff + m * 2048 + k * 1024); } while (0)
#define PG8_LDB(dst, b, h) do { _Pragma("unroll") for (int n = 0; n < 2; ++n) _Pragma("unroll") for (int k = 0; k < 2; ++k) dst[n][k] = *(const PG8_LAS bf16x8*)(lds + PG8_SB(b, h) + boff + n * 2048 + k * 1024); } while (0)
#define PG8_MMA(ai, bj, At, Bt) do { __builtin_amdgcn_s_setprio(1); _Pragma("unroll") for (int m = 0; m < 4; ++m) _Pragma("unroll") for (int n = 0; n < 2; ++n) _Pragma("unroll") for (int k = 0; k < 2; ++k) \
        acc[ai][bj][m][n] = __builtin_amdgcn_mfma_f32_16x16x32_bf16(Bt[n][k], At[m][k], acc[ai][bj][m][n], 0, 0, 0); __builtin_amdgcn_s_setprio(0); } while (0)
#define PG8_WAIT_V(n) asm volatile("s_waitcnt vmcnt(" #n ")" ::: "memory")
#define PG8_WAIT_L(n) asm volatile("s_waitcnt lgkmcnt(" #n ")" ::: "memory")
#define PG8_BAR __builtin_amdgcn_s_barrier()
#define PG8_SCHED __builtin_amdgcn_sched_barrier(0)
    Unit cur, nxt; int ui = 0;
    if (!S.next(0, cur)) return;
    f32x4 acc[2][2][4][2];
#pragma unroll
    for (int a = 0; a < 2; ++a)
#pragma unroll
        for (int b = 0; b < 2; ++b)
#pragma unroll
            for (int m = 0; m < 4; ++m)
#pragma unroll
                for (int n = 0; n < 2; ++n) acc[a][b][m][n] = (f32x4){0.f, 0.f, 0.f, 0.f};
    bf16x8 At[4][2], B0[2][2], B1[2][2];
    const char* cA = (const char*)g.A + (size_t)cur.pm * tstep; const char* cB = (const char*)g.Bt + (size_t)cur.pn * tstep;
    S.a_ready(cur);
    if constexpr (SP2) {
        PG8_STAGE(PG8_SB(0, 0), cB, voffB); PG8_STAGE(PG8_SB(0, 1), cB + hstep, voffB); PG8_STAGE(PG8_SA(0, 0), cA, voffA); PG8_STAGE(PG8_SA(0, 1), cA + hstep, voffA);
        if (wr == 1) PG8_BAR;
        PG8_WAIT_V(2); PG8_BAR;
        PG8_STAGE(PG8_SB(1, 0), cB + kstep, voffB); PG8_STAGE(PG8_SA(1, 0), cA + kstep, voffA); PG8_STAGE(PG8_SB(1, 1), cB + hstep + kstep, voffB);
        PG8_WAIT_V(6); PG8_BAR;
    } else {
        PG8_STAGE(PG8_SB(0, 0), cB, voffB); PG8_STAGE(PG8_SA(0, 0), cA, voffA); PG8_STAGE(PG8_SB(0, 1), cB + hstep, voffB); PG8_STAGE(PG8_SA(0, 1), cA + hstep, voffA);
        if (wr == 1) PG8_BAR;
        PG8_WAIT_V(4); PG8_BAR;
        PG8_STAGE(PG8_SB(1, 0), cB + kstep, voffB); PG8_STAGE(PG8_SA(1, 0), cA + kstep, voffA); PG8_STAGE(PG8_SB(1, 1), cB + hstep + kstep, voffB);
        PG8_WAIT_V(6); PG8_BAR;
    }
    for (;;) {
        const bool has_next = S.next(ui + 1, nxt);
        const char* nA = has_next ? (const char*)g.A + (size_t)nxt.pm * tstep : cA; const char* nB = has_next ? (const char*)g.Bt + (size_t)nxt.pn * tstep : cB;
        for (int t = 0; t < nt; t += 2) {
            const bool last = (t == nt - 2);
            const char* a1 = cA + (size_t)(t + 1) * kstep;
            const char* a2 = last ? nA : cA + (size_t)(t + 2) * kstep; const char* b2 = last ? nB : cB + (size_t)(t + 2) * kstep;
            const char* a3 = a2 + kstep; const char* b3 = b2 + kstep;
            if (last && has_next) S.a_ready(nxt);
            if constexpr (SP2) {
            PG8_LDB(B0, 0, 0); PG8_LDB(B1, 0, 1); PG8_SCHED; PG8_LDA(At, 0, 0); PG8_STAGE(PG8_SA(1, 1), a1 + hstep, voffA);
            PG8_WAIT_V(8); PG8_WAIT_L(0); PG8_BAR; PG8_MMA(0, 0, At, B0); PG8_MMA(0, 1, At, B1); PG8_BAR; PG8_SCHED;
            PG8_LDA(At, 0, 1); PG8_STAGE(PG8_SB(0, 0), b2, voffB); PG8_STAGE(PG8_SB(0, 1), b2 + hstep, voffB); PG8_STAGE(PG8_SA(0, 0), a2, voffA);
            PG8_WAIT_V(8); PG8_WAIT_L(0); PG8_BAR; PG8_MMA(1, 0, At, B0); PG8_MMA(1, 1, At, B1); PG8_BAR; PG8_SCHED;
            PG8_LDB(B0, 1, 0); PG8_LDB(B1, 1, 1); PG8_SCHED; PG8_LDA(At, 1, 0); PG8_STAGE(PG8_SA(0, 1), a2 + hstep, voffA);
            PG8_WAIT_V(8); PG8_WAIT_L(0); PG8_BAR; PG8_MMA(0, 0, At, B0); PG8_MMA(0, 1, At, B1); PG8_BAR; PG8_SCHED;
            PG8_LDA(At, 1, 1); PG8_STAGE(PG8_SB(1, 0), b3, voffB); PG8_STAGE(PG8_SB(1, 1), b3 + hstep, voffB); PG8_STAGE(PG8_SA(1, 0), a3, voffA);
            PG8_WAIT_V(8); PG8_WAIT_L(0); PG8_BAR; PG8_MMA(1, 0, At, B0); PG8_MMA(1, 1, At, B1); PG8_BAR; PG8_SCHED;
            } else {
            PG8_LDB(B0, 0, 0); PG8_SCHED; PG8_LDA(At, 0, 0); PG8_STAGE(PG8_SA(1, 1), a1 + hstep, voffA);
            PG8_WAIT_L(8); PG8_BAR; PG8_WAIT_L(0); PG8_MMA(0, 0, At, B0); PG8_BAR; PG8_SCHED;
            PG8_LDB(B1, 0, 1); PG8_STAGE(PG8_SB(0, 0), b2, voffB);
            PG8_BAR; PG8_WAIT_L(0); PG8_MMA(0, 1, At, B1); PG8_BAR;
            PG8_LDA(At, 0, 1); PG8_STAGE(PG8_SA(0, 0), a2, voffA);
            PG8_BAR; PG8_WAIT_L(0); PG8_MMA(1, 0, At, B0); PG8_BAR; PG8_SCHED;
            PG8_STAGE(PG8_SB(0, 1), b2 + hstep, voffB);
            PG8_WAIT_V(6); PG8_BAR; PG8_MMA(1, 1, At, B1); PG8_BAR;
            PG8_LDB(B0, 1, 0); PG8_SCHED; PG8_LDA(At, 1, 0); PG8_STAGE(PG8_SA(0, 1), a2 + hstep, voffA);
            PG8_WAIT_L(8); PG8_BAR; PG8_WAIT_L(0); PG8_MMA(0, 0, At, B0); PG8_BAR; PG8_SCHED;
            PG8_LDB(B1, 1, 1); PG8_STAGE(PG8_SB(1, 0), b3, voffB);
            PG8_BAR; PG8_WAIT_L(0); PG8_MMA(0, 1, At, B1); PG8_BAR;
            PG8_LDA(At, 1, 1); PG8_STAGE(PG8_SA(1, 0), a3, voffA);
            PG8_BAR; PG8_WAIT_L(0); PG8_MMA(1, 0, At, B0); PG8_BAR; PG8_SCHED;
            PG8_STAGE(PG8_SB(1, 1), b3 + hstep, voffB);
            PG8_WAIT_V(6); PG8_BAR; PG8_MMA(1, 1, At, B1); PG8_BAR;
            }
        }
        if constexpr (ALIGN_EPI) { if (wr == 0) PG8_BAR; }
        if constexpr (!Epi::AFTER_DRAIN) { E(acc, cur, wr, wc, fr, fq); S.done(cur); }
        if (!has_next) break;
#pragma unroll
        for (int a = 0; a < 2; ++a)
#pragma unroll
            for (int b = 0; b < 2; ++b)
#pragma unroll
                for (int m = 0; m < 4; ++m)
#pragma unroll
                    for (int n = 0; n < 2; ++n) acc[a][b][m][n] = (f32x4){0.f, 0.f, 0.f, 0.f};
        cur = nxt; cA = nA; cB = nB; ++ui;
        if constexpr (ALIGN_EPI) { if (wr == 1) PG8_BAR; }
    }
    PG8_WAIT_V(0);
    if constexpr (!ALIGN_EPI) { if (wr == 0) PG8_BAR; }
    PG8_BAR;
    if constexpr (Epi::AFTER_DRAIN) { E.fused(acc, cur, wr, wc, fr, fq, lds, wid, lane); S.done(cur); }
#undef PG8_SA
#undef PG8_SB
#undef PG8_STAGE
#undef PG8_LDA
#undef PG8_LDB
#undef PG8_MMA
#undef PG8_WAIT_V
#undef PG8_WAIT_L
#undef PG8_BAR
#undef PG8_SCHED
}
}
#define LAS __attribute__((address_space(3)))
#define GAS __attribute__((address_space(1)))
typedef float f32x4 __attribute__((ext_vector_type(4)));
typedef unsigned u32x4 __attribute__((ext_vector_type(4)));
typedef unsigned u32x2 __attribute__((ext_vector_type(2)));
typedef __bf16 bf16x2_t __attribute__((ext_vector_type(2)));
typedef GAS unsigned gu32;

constexpr int NWAVES = 8, NTHR = 512;
constexpr int RING_BYTES = 139264, LDSCTL_OFF = RING_BYTES, MISC_OFF = LDSCTL_OFF + 320, LDS_BYTES = 147456;

constexpr size_t WS_CTL   = 245 * MiB;
constexpr size_t CTL_ZERO_BYTES = 32768;
constexpr size_t WS_WIN0  = 246 * MiB;
constexpr size_t WS_WOUT0 = 250 * MiB;
constexpr size_t WS_WIN1  = 252 * MiB;
constexpr size_t WS_WOUT1 = 258 * MiB;
constexpr size_t WS_WQ0   = 260 * MiB;
constexpr size_t WS_WQ1   = 264 * MiB;
constexpr size_t WS_K12   = 268 * MiB;
constexpr size_t WS_MISC  = 269 * MiB;
constexpr size_t WS_UT    = 270 * MiB;
constexpr size_t WS_VT    = 302 * MiB;
constexpr int ROWB = 768;
constexpr size_t WS_SC    = 334 * MiB;
constexpr size_t WS_XB    = 173 * MiB;
constexpr size_t WS_CB    = 355 * MiB;
constexpr size_t WS_KT    = 336 * MiB;
constexpr size_t WS_XS    = 366 * MiB;
constexpr size_t WS_END2  = 402 * MiB;
constexpr int CW_BAR = 4096;
constexpr size_t SM_BIASF = 0, SM_RC = 8192, SM_RS = 12288, SM_GWT = 16384, SM_LN1G = 81920, SM_LN1B = 90112, SM_LN2G = 98304, SM_LN2B = 106496, SM_CONVW = 114688, SM_CONVB = 178176,
                 SM_CLNG = 180224, SM_CLNB = 182272, SM_QNG = 184320, SM_KNG = 184576, SM_ABBOUT = 184832, SM_MLBIN = 188928, SM_MLNG = 201280, SM_MLBOUT = 205376, SM_W2 = 212992;
#define SMF(ws_, off_) ((const float*)((ws_) + WS_MISC + (off_)))

#define LDS_WAIT() asm volatile("s_waitcnt lgkmcnt(0)" ::: "memory")
#define VM_WAIT() asm volatile("s_waitcnt vmcnt(0)" ::: "memory")
typedef float f32x2_t_ __attribute__((ext_vector_type(2)));
__device__ __forceinline__ unsigned pk2(float lo, float hi) { f32x2_t_ v = {lo, hi}; bf16x2_t b = __builtin_convertvector(v, bf16x2_t); return __builtin_bit_cast(unsigned, b); }
__device__ __forceinline__ float bflo(unsigned u) { return __uint_as_float(u << 16); }
__device__ __forceinline__ float bfhi(unsigned u) { return __uint_as_float(u & 0xffff0000u); }
__device__ __forceinline__ float dot2bf(unsigned a, unsigned b, float c) { return __builtin_amdgcn_fdot2_f32_bf16(__builtin_bit_cast(bf16x2_t, a), __builtin_bit_cast(bf16x2_t, b), c, false); }
__device__ __forceinline__ float dot8bf(u32x4 a, u32x4 b, float c) { c = dot2bf(a.x, b.x, c); c = dot2bf(a.y, b.y, c); c = dot2bf(a.z, b.z, c); return dot2bf(a.w, b.w, c); }
__device__ __forceinline__ float sigmoidf_(float x) { return 1.f / (1.f + __expf(-x)); }
__device__ __forceinline__ float rl_f(float v, int l) { return __uint_as_float(__builtin_amdgcn_readlane(__float_as_uint(v), l)); }
__device__ __forceinline__ int rl_i(int v, int l) { return __builtin_amdgcn_readlane(v, l); }

#define XB_TMO      128
#define XB_XCNT(j)  (256  + 64 * (j))
#define XB_XSUB(j)  (1280 + 64 * (j))
#define XB_XGEN(j)  (2304 + 64 * (j))
#define XB_TOP      3328
#define XB_TOPGEN   3392
#define XCD_BAR_WORDS 3456
#define XB_SPIN_CAP (1u << 18)
__device__ __forceinline__ unsigned xb_ld(unsigned* p)              { return __hip_atomic_load(p, __ATOMIC_RELAXED, __HIP_MEMORY_SCOPE_AGENT); }
__device__ __forceinline__ unsigned xb_add(unsigned* p, unsigned v) { return __hip_atomic_fetch_add(p, v, __ATOMIC_RELAXED, __HIP_MEMORY_SCOPE_AGENT); }
__device__ __forceinline__ unsigned xb_xcc_id() { return (unsigned)__builtin_amdgcn_s_getreg((3 << 11) | 20) & 0xFu; }
#define XB_SPIN(cond, bar) do { unsigned _sp = 0; while (cond) { __builtin_amdgcn_s_sleep(1); \
    if ((++_sp & 255u) == 0u) { if (xb_ld(&(bar)[XB_TMO])) break; if (_sp > XB_SPIN_CAP) { atomicAdd(&(bar)[XB_TMO], 1u); break; } } } } while (0)
struct XcdBarrier { unsigned* bar; unsigned x; volatile LAS unsigned* st; };
__device__ __forceinline__ XcdBarrier xcd_barrier_post(unsigned* bar, volatile LAS unsigned* st, int wave) {
    XcdBarrier b; b.bar = bar; b.x = xb_xcc_id(); b.st = st;
    if (wave == 0 && fresh_lane() == 0) (void)xb_add(&bar[XB_XCNT(b.x)], 1u);
    return b;
}
__device__ __forceinline__ void xcd_barrier_complete(unsigned* bar, unsigned x, unsigned& nloc, unsigned& nx) {
    const unsigned G = gridDim.x * gridDim.y * gridDim.z;
    unsigned sum, cnt, mine, sp = 0u;
    for (;;) {
        sum = 0u; cnt = 0u; mine = 0u;
#pragma unroll
        for (unsigned j = 0; j < 16; ++j) { const unsigned c = xb_ld(&bar[XB_XCNT(j)]); sum += c; cnt += (c > 0u) ? 1u : 0u; mine = (j == x) ? c : mine; }
        if (sum == G) break;
        __builtin_amdgcn_s_sleep(1);
        if ((++sp & 255u) == 0u) { if (xb_ld(&bar[XB_TMO])) break; if (sp > XB_SPIN_CAP) { atomicAdd(&bar[XB_TMO], 1u); break; } }
    }
    nloc = mine > 0u ? mine : 1u; nx = cnt > 0u ? cnt : 1u;
}
__device__ __forceinline__ void xcd_barrier(const XcdBarrier& b, int wave) {
    asm volatile("s_waitcnt vmcnt(0)" ::: "memory");
    __syncthreads();
    if (wave == 0 && fresh_lane() == 0) {
        unsigned* bar = b.bar;
        __builtin_amdgcn_s_waitcnt(0);
        unsigned nloc = b.st[0], nx = b.st[1];
        if (nloc == 0u) { xcd_barrier_complete(bar, b.x, nloc, nx); b.st[0] = nloc; b.st[1] = nx; }
        const unsigned old = xb_add(&bar[XB_XSUB(b.x)], 1u);
        const unsigned gen = old / nloc;
        if (old + 1u == (gen + 1u) * nloc) {
            __builtin_amdgcn_fence(__ATOMIC_RELEASE, "agent");
            asm volatile("s_waitcnt vmcnt(0)" ::: "memory");
            const unsigned og = xb_add(&bar[XB_TOP], 1u);
            const unsigned tg = og / nx;
            if (og + 1u == (tg + 1u) * nx) xb_add(&bar[XB_TOPGEN], 1u);
            else XB_SPIN(xb_ld(&bar[XB_TOPGEN]) == tg, bar);
            __builtin_amdgcn_fence(__ATOMIC_ACQUIRE, "agent");
            xb_add(&bar[XB_XGEN(b.x)], 1u);
            asm volatile("s_waitcnt vmcnt(0)" ::: "memory");
        } else {
            XB_SPIN(xb_ld(&bar[XB_XGEN(b.x)]) == gen, bar);
            __builtin_amdgcn_fence(__ATOMIC_ACQUIRE, "agent");
            asm volatile("s_waitcnt vmcnt(0)" ::: "memory");
        }
    }
    __syncthreads();
}

struct Args { const float* in[30]; float* out; unsigned char* ws; int ph_lo, ph_hi; };
enum { I_X = 0, I_C, I_CTX, I_CCTX, I_WMOD, I_BMOD, I_LN1G, I_LN1B, I_LN2G, I_LN2B, I_ABWIN, I_ABBIN, I_CONVW, I_CONVB, I_CLNG, I_CLNB, I_QNG, I_KNG, I_ABWOUT, I_ABBOUT,
       I_MLWIN, I_MLBIN, I_MLNG, I_MLWOUT, I_MLBOUT, I_PWQ, I_PK1, I_PK2, I_PU, I_PV };

__host__ __device__ __forceinline__ int perm_in0(int n) {
    if (n < 512) return 256 * (n >> 7) + (n & 127);
    if (n < 1024) { const int c = n - 512; return 256 * (c >> 7) + 128 + (c & 127); }
    if (n < 1536) { const int c = n - 1024, hq = c >> 6, dd = c & 63; return 1024 + 256 * (hq >> 2) + 128 * (dd >> 5) + 32 * (hq & 3) + (dd & 31); }
    if (n < 1664) { const int c = n - 1536, hk = c >> 6, dd = c & 63; return 1536 + 128 * (dd >> 5) + 32 * hk + (dd & 31); }
    { const int c = n - 1664, hv = c >> 6, dd = c & 63; return 1536 + 128 * (dd >> 5) + 32 * (2 + hv) + (dd & 31); }
}
template <bool PERM0>
__device__ __forceinline__ void p0_transpose_item(const float* W, int ld, int nblk, bf16_t* WT, LAS float* scr, int item, int lane) {
    const int kb = item / nblk, nb = item % nblk, k0 = 64 * kb, n0 = 32 * nb;
    float tv[32];
#pragma unroll
    for (int i = 0; i < 32; ++i) { const int kk = 2 * i + (lane >> 5); tv[i] = W[(size_t)(k0 + kk) * ld + n0 + (lane & 31)]; }
#pragma unroll
    for (int i = 0; i < 32; ++i) { const int kk = 2 * i + (lane >> 5); scr[kk * 33 + (lane & 31)] = tv[i]; }
    LDS_WAIT(); asm volatile("" ::: "memory");
    const int c = lane & 7;
#pragma unroll
    for (int j = 0; j < 4; ++j) { const int n = (lane >> 3) + 8 * j; const LAS float* s = scr + (8 * c) * 33 + n;
        u32x4 o; o.x = pk2(s[0 * 33], s[1 * 33]); o.y = pk2(s[2 * 33], s[3 * 33]); o.z = pk2(s[4 * 33], s[5 * 33]); o.w = pk2(s[6 * 33], s[7 * 33]);
        const int row = PERM0 ? perm_in0(n0 + n) : (n0 + n);
        *(u32x4*)(WT + (size_t)row * 1024 + k0 + 8 * c) = o; }
    LDS_WAIT(); asm volatile("" ::: "memory");
}
__device__ __forceinline__ void p0_convert(const float* src, bf16_t* dst, size_t n8, int gw, int ngw, int lane) {
    for (size_t i = (size_t)gw * 64 + lane; i < n8; i += (size_t)ngw * 64) {
        const f32x4 a = ((const f32x4*)src)[2 * i], b = ((const f32x4*)src)[2 * i + 1];
        u32x4 o; o.x = pk2(a.x, a.y); o.y = pk2(a.z, a.w); o.z = pk2(b.x, b.y); o.w = pk2(b.z, b.w);
        ((u32x4*)dst)[i] = o;
    }
}
__device__ __forceinline__ void p0_prologue(const Args& A, LAS unsigned char* lds, int vcu, int G, int tid) {
    const int lane = tid & 63, wave = __builtin_amdgcn_readfirstlane(tid >> 6);
    unsigned char* ws = A.ws;
    for (int it = vcu; it < 256; it += G) {
        const int l = it / 128, n0 = (it % 128) * 48; const bool act = lane < 48;
        LAS float* sl = (LAS float*)lds; LAS float* red = sl + 9 * 1024;
        for (int i = tid; i < 9 * 1024; i += NTHR) { const int j = i >> 10, k = i & 1023; const float x = j < NB ? A.in[I_C][j * D + k] : A.in[I_CCTX][k]; sl[i] = x / (1.f + expf(-x)); }
        __syncthreads();
        float acc[9];
#pragma unroll
        for (int j = 0; j < 9; ++j) acc[j] = 0.f;
        const float* w = A.in[I_WMOD] + ((size_t)l * D + wave * 128) * NMOD + n0 + lane;
        for (int kk0 = 0; kk0 < 128; kk0 += 32) {
            float wv[32];
#pragma unroll
            for (int i = 0; i < 32; ++i) wv[i] = act ? w[(size_t)(kk0 + i) * NMOD] : 0.f;
#pragma unroll
            for (int i = 0; i < 32; ++i) { const int k = wave * 128 + kk0 + i;
#pragma unroll
                for (int j = 0; j < 9; ++j) acc[j] += sl[j * 1024 + k] * wv[i]; } }
#pragma unroll
        for (int j = 0; j < 9; ++j) red[(wave * 9 + j) * 64 + lane] = acc[j];
        __syncthreads();
        float* MOD = (float*)(ws + WS_MOD);
        for (int i = tid; i < 576; i += NTHR) { const int j = i >> 6, ln = i & 63; if (ln >= 48) continue; float s = A.in[I_BMOD][l * NMOD + n0 + ln];
#pragma unroll
            for (int w8 = 0; w8 < 8; ++w8) s += red[(w8 * 9 + j) * 64 + ln];
            MOD[((size_t)l * 9 + j) * NMOD + n0 + ln] = s; }
        __syncthreads();
    }
    { const int job = G - 1 - vcu;
        float* BIASF = (float*)(ws + WS_MISC); float* RC = (float*)(ws + WS_MISC + 8192); float* RS = (float*)(ws + WS_MISC + 12288); float* GWT = (float*)(ws + WS_MISC + 16384);
        if (job == 0) for (int n = tid; n < AB_IN; n += NTHR) BIASF[perm_in0(n)] = A.in[I_ABBIN][n];
        if (job == 0) for (int i = tid; i < 1024; i += NTHR) { const int pos = i >> 4, fi = i & 15; const float ang = (float)pos * powf(10000.f, -(float)fi / 16.f); RC[i] = cosf(ang); RS[i] = sinf(ang); }
        if (job == 1) for (int i = tid; i < 16 * 1024; i += NTHR) { const int j = i >> 10, k = i & 1023; GWT[i] = A.in[I_MLWIN][(size_t)k * C_IN + 3072 + j]; }
        if (job == 2) for (int i = tid; i < 16 * 512; i += NTHR) { const int jp = i >> 9, c = i & 511; const float w0 = A.in[I_CONVW][(2 * jp) * 512 + c], w1 = jp < 15 ? A.in[I_CONVW][(2 * jp + 1) * 512 + c] : 0.f;
            ((unsigned*)(ws + WS_MISC + SM_W2))[i] = pk2(w0, w1); }
        if (job == 3) { struct CP { int idx; size_t off; int n; };
          const CP cps[14] = {{I_LN1G, SM_LN1G, 2 * D}, {I_LN1B, SM_LN1B, 2 * D}, {I_LN2G, SM_LN2G, 2 * D}, {I_LN2B, SM_LN2B, 2 * D}, {I_CONVW, SM_CONVW, 31 * 512}, {I_CONVB, SM_CONVB, 512}, {I_CLNG, SM_CLNG, 512},
                              {I_CLNB, SM_CLNB, 512}, {I_QNG, SM_QNG, 64}, {I_KNG, SM_KNG, 64}, {I_ABBOUT, SM_ABBOUT, D}, {I_MLBIN, SM_MLBIN, C_IN}, {I_MLNG, SM_MLNG, D}, {I_MLBOUT, SM_MLBOUT, D}};
#pragma unroll
          for (int c = 0; c < 14; ++c) { const float* s = A.in[cps[c].idx]; float* d = (float*)(ws + WS_MISC + cps[c].off); for (int i = tid; i < cps[c].n; i += NTHR) d[i] = s[i]; } }
    }
    const int gw = vcu * NWAVES + wave, NGW = G * NWAVES;
    LAS float* scr = (LAS float*)(lds + wave * 16384);
    constexpr int I_IN0 = 16 * 56, I_SQ = 16 * 32, I_IN1 = 16 * 96, I_WQ = 16 * 64;
    constexpr int NITEMS = I_IN0 + I_SQ + I_IN1 + I_SQ + 2 * I_WQ;
    for (int it = gw; it < NITEMS; it += NGW) {
        int r = it;
        if (r < I_IN0) { p0_transpose_item<true>(A.in[I_ABWIN], AB_IN, 56, (bf16_t*)(ws + WS_WIN0), scr, r, lane); continue; } r -= I_IN0;
        if (r < I_SQ) { p0_transpose_item<false>(A.in[I_ABWOUT], D, 32, (bf16_t*)(ws + WS_WOUT0), scr, r, lane); continue; } r -= I_SQ;
        if (r < I_IN1) { p0_transpose_item<false>(A.in[I_MLWIN], C_IN, 96, (bf16_t*)(ws + WS_WIN1), scr, r, lane); continue; } r -= I_IN1;
        if (r < I_SQ) { p0_transpose_item<false>(A.in[I_MLWOUT], D, 32, (bf16_t*)(ws + WS_WOUT1), scr, r, lane); continue; } r -= I_SQ;
        if (r < I_WQ) { p0_transpose_item<false>(A.in[I_PWQ], 2048, 64, (bf16_t*)(ws + WS_WQ0), scr, r, lane); continue; } r -= I_WQ;
        p0_transpose_item<false>(A.in[I_PWQ] + (size_t)D * 2048, 2048, 64, (bf16_t*)(ws + WS_WQ1), scr, r, lane);
    }
    p0_convert(A.in[I_PK1], (bf16_t*)(ws + WS_K12), (size_t)8 * 128 * 128 / 8, gw, NGW, lane);
    p0_convert(A.in[I_PK2], (bf16_t*)(ws + WS_K12) + 131072, (size_t)8 * 128 * 128 / 8, gw, NGW, lane);
    p0_convert(A.in[I_PK1] + 131072, (bf16_t*)(ws + WS_K12) + 2 * 131072, (size_t)8 * 128 * 128 / 8, gw, NGW, lane);
    p0_convert(A.in[I_PK2] + 131072, (bf16_t*)(ws + WS_K12) + 3 * 131072, (size_t)8 * 128 * 128 / 8, gw, NGW, lane);
    for (int pr0 = gw; pr0 < 2 * 16384; pr0 += 2 * NGW) {
        f32x4 v[2][2][4];
#pragma unroll
        for (int q = 0; q < 2; ++q) { const int pr = pr0 + q * NGW; if (pr < 2 * 16384) {
#pragma unroll
            for (int h = 0; h < 2; ++h) { const int rr = 2 * pr + h, tab = rr >> 14, row = rr & 16383;
                const float* src = (tab < 2 ? A.in[I_PU] : A.in[I_PV]) + ((size_t)(tab & 1) * 16384 + row) * D;
#pragma unroll
                for (int j = 0; j < 4; ++j) v[q][h][j] = ((const f32x4*)src)[lane + 64 * j]; } } }
#pragma unroll
        for (int q = 0; q < 2; ++q) { const int pr = pr0 + q * NGW; if (pr < 2 * 16384) {
            typedef float f32x16_ __attribute__((ext_vector_type(16))); typedef unsigned u32x6_ __attribute__((ext_vector_type(6)));
            f32x16_ ab[2];
#pragma unroll
            for (int h = 0; h < 2; ++h) { const int rr = 2 * pr + h; float mx = 0.f;
#pragma unroll
                for (int j = 0; j < 4; ++j) mx = fmaxf(mx, fmaxf(fmaxf(fabsf(v[q][h][j].x), fabsf(v[q][h][j].y)), fmaxf(fabsf(v[q][h][j].z), fabsf(v[q][h][j].w))));
#pragma unroll
                for (int o = 1; o < 64; o <<= 1) mx = fmaxf(mx, __shfl_xor(mx, o));
                mx = fmaxf(mx, 1e-30f);
                const float inv = 7.5f / mx;
#pragma unroll
                for (int j = 0; j < 4; ++j) { ab[h][4 * j] = v[q][h][j].x * inv; ab[h][4 * j + 1] = v[q][h][j].y * inv; ab[h][4 * j + 2] = v[q][h][j].z * inv; ab[h][4 * j + 3] = v[q][h][j].w * inv; }
                if (lane == 0) ((float*)(ws + WS_SC))[rr] = mx * (1.f / 7.5f); }
            f32x16_ pe, po;
#pragma unroll
            for (int i = 0; i < 8; ++i) { pe[i] = ab[0][2 * i]; po[i] = ab[0][2 * i + 1]; pe[8 + i] = ab[1][2 * i]; po[8 + i] = ab[1][2 * i + 1]; }
            const u32x6_ p = __builtin_amdgcn_cvt_scalef32_2xpk16_fp6_f32(pe, po, 1.0f);
#pragma unroll
            for (int h = 0; h < 2; ++h) { const int rr = 2 * pr + h, tab = rr >> 14, row = rr & 16383;
                unsigned* dst = (unsigned*)(ws + (tab < 2 ? WS_UT : WS_VT) + ((size_t)(tab & 1) * 16384 + row) * ROWB) + lane * 3;
                dst[0] = p[3 * h]; dst[1] = p[3 * h + 1]; dst[2] = p[3 * h + 2]; } } }
    }
}

__device__ __forceinline__ float wsum(float v) {
    v += xshfl<1>(v); v += xshfl<2>(v); v += xshfl<4>(v); v += xshfl<8>(v); v += xshfl<16>(v); v += xshfl<32>(v);
    return v;
}
__device__ __forceinline__ void row_load(const float* row, int lane, f32x4 (&v)[4]) {
    const f32x4* p = (const f32x4*)row + lane;
#pragma unroll
    for (int j = 0; j < 4; ++j) v[j] = p[64 * j];
}
__device__ __forceinline__ void row_norm(f32x4 (&v)[4]) {
    float s = 0.f;
#pragma unroll
    for (int j = 0; j < 4; ++j) s += (v[j].x + v[j].y) + (v[j].z + v[j].w);
    const float mean = wsum(s) * (1.f / D); float s2 = 0.f;
#pragma unroll
    for (int j = 0; j < 4; ++j) { v[j] = v[j] - mean; s2 += (v[j].x * v[j].x + v[j].y * v[j].y) + (v[j].z * v[j].z + v[j].w * v[j].w); }
    const float rstd = rsqrtf(wsum(s2) * (1.f / D) + EPS);
#pragma unroll
    for (int j = 0; j < 4; ++j) v[j] = v[j] * rstd;
}
__device__ __forceinline__ void row_store_mod_bf16(bf16_t* orow, int lane, const f32x4 (&v)[4], const float* sh, const float* sc) {
    u32x2* o8 = (u32x2*)orow + lane;
#pragma unroll
    for (int j = 0; j < 4; ++j) { const f32x4 a = ((const f32x4*)sc)[lane + 64 * j], b = ((const f32x4*)sh)[lane + 64 * j]; const f32x4 y = v[j] * (a + 1.f) + b;
        u32x2 o; o.x = pk2(y.x, y.y); o.y = pk2(y.z, y.w); o8[64 * j] = o; }
}
__device__ __forceinline__ void p1_ln_mod(const Args& A, int gw, int NGW, int lane) {
    const float* MOD = (const float*)(A.ws + WS_MOD); bf16_t* HBF = (bf16_t*)(A.ws + WS_HBF);
    for (int r0 = gw; r0 < TT; r0 += 2 * NGW) {
        const int r1 = r0 + NGW; const bool two = r1 < TT;
        const float* x0 = r0 < TL ? A.in[I_X] + (size_t)r0 * D : A.in[I_CTX] + (size_t)(r0 - TL) * D;
        const float* x1 = two ? (r1 < TL ? A.in[I_X] + (size_t)r1 * D : A.in[I_CTX] + (size_t)(r1 - TL) * D) : x0;
        f32x4 v0[4], v1[4]; row_load(x0, lane, v0); row_load(x1, lane, v1);
        const float* md0 = MOD + (size_t)mod_row(r0) * NMOD; row_norm(v0); row_store_mod_bf16(HBF + (size_t)r0 * D, lane, v0, md0, md0 + D);
        if (two) { const float* md1 = MOD + (size_t)mod_row(r1) * NMOD; row_norm(v1); row_store_mod_bf16(HBF + (size_t)r1 * D, lane, v1, md1, md1 + D); }
    }
}
__device__ __forceinline__ void row_load_bf16(const bf16_t* row, int lane, f32x4 (&v)[4]) {
    const u32x2* p = (const u32x2*)row + lane;
#pragma unroll
    for (int j = 0; j < 4; ++j) { const u32x2 w = p[64 * j]; v[j].x = bflo(w.x); v[j].y = bfhi(w.x); v[j].z = bflo(w.y); v[j].w = bfhi(w.y); }
}
__device__ __forceinline__ void p5_ln_ln_mod(const Args& A, int layer, int nrows, int gw, int NGW, int lane) {
    const float* MOD = (const float*)(A.ws + WS_MOD) + (size_t)layer * 9 * NMOD; bf16_t* HBF = (bf16_t*)(A.ws + WS_HBF); const bf16_t* XB = (const bf16_t*)(A.ws + WS_XB);
    const float* gam = SMF(A.ws, SM_LN1G) + layer * D; const float* bet = SMF(A.ws, SM_LN1B) + layer * D;
    for (int r0 = gw; r0 < nrows; r0 += 2 * NGW) {
        const int r1 = r0 + NGW; const bool two = r1 < nrows;
        bf16_t* XS = (bf16_t*)(A.ws + WS_XS);
        u32x2* x0 = (u32x2*)(XS + (size_t)r0 * D); u32x2* x1 = (u32x2*)(XS + (size_t)(two ? r1 : r0) * D);
        f32x4 v0[4], v1[4]; row_load_bf16(XB + (size_t)r0 * D, lane, v0); row_load_bf16(XB + (size_t)(two ? r1 : r0) * D, lane, v1);
        { const float* md = MOD + (size_t)mod_row(r0) * NMOD; row_norm(v0);
#pragma unroll
          for (int j = 0; j < 4; ++j) { v0[j] = v0[j] * ((const f32x4*)gam)[lane + 64 * j] + ((const f32x4*)bet)[lane + 64 * j]; u32x2 w; w.x = pk2(v0[j].x, v0[j].y); w.y = pk2(v0[j].z, v0[j].w); x0[lane + 64 * j] = w; }
          row_norm(v0); row_store_mod_bf16(HBF + (size_t)r0 * D, lane, v0, md + 3 * D, md + 4 * D); }
        if (two) { const float* md = MOD + (size_t)mod_row(r1) * NMOD; row_norm(v1);
#pragma unroll
          for (int j = 0; j < 4; ++j) { v1[j] = v1[j] * ((const f32x4*)gam)[lane + 64 * j] + ((const f32x4*)bet)[lane + 64 * j]; u32x2 w; w.x = pk2(v1[j].x, v1[j].y); w.y = pk2(v1[j].z, v1[j].w); x1[lane + 64 * j] = w; }
          row_norm(v1); row_store_mod_bf16(HBF + (size_t)r1 * D, lane, v1, md + 3 * D, md + 4 * D); }
    }
}
namespace epi {
using pg8::Unit; using pg8::f32x4;
typedef unsigned u32x4 __attribute__((ext_vector_type(4)));
__device__ __forceinline__ u32x4 pack8(const f32x4& a, const f32x4& b) { u32x4 w; w.x = pk2(a.x, a.y); w.y = pk2(a.z, a.w); w.z = pk2(b.x, b.y); w.w = pk2(b.z, b.w); return w; }

struct EpiPlain {
    static constexpr bool PERM = true, AFTER_DRAIN = false;
    bf16_t* O; int ldc;
    __device__ __forceinline__ void operator()(const f32x4 (&acc)[2][2][4][2], const Unit& u, int wr, int wc, int fr, int fq) const {
        asm volatile("" : "+v"(fr), "+v"(fq));
        const int row0 = u.pm * 256 + wr * 64 + fr, col0 = u.pn * 256 + wc * 32 + 8 * fq;
#pragma unroll
        for (int ai = 0; ai < 2; ++ai)
#pragma unroll
            for (int m = 0; m < 4; ++m) { bf16_t* rowp = O + (size_t)(row0 + ai * 128 + m * 16) * ldc + col0;
#pragma unroll
                for (int bj = 0; bj < 2; ++bj) *(u32x4*)(rowp + bj * 128) = pack8(acc[ai][bj][m][0], acc[ai][bj][m][1]); }
    }
};

struct EpiIn1 {
    static constexpr bool PERM = true, AFTER_DRAIN = false;
    bf16_t *QM, *KM, *KT, *VT, *OM; const float* bias;
    __device__ __forceinline__ void operator()(const f32x4 (&acc)[2][2][4][2], const Unit& u, int wr, int wc, int fr, int fq) const {
        asm volatile("" : "+v"(fr), "+v"(fq));
        const int row0 = u.pm * 256 + wr * 64 + fr, pn = u.pn;
        const int bcol0 = pn * 256 + wc * 32 + 8 * fq;
        if (pn >= 8 && u.pm >= TL / 256) return;
#pragma unroll
        for (int ai = 0; ai < 2; ++ai)
#pragma unroll
            for (int m = 0; m < 4; ++m) { const int r = row0 + ai * 128 + m * 16;
                int fqi = fq; asm volatile("" : "+v"(fqi));
                const float* bp = bias + pn * 256 + wc * 32 + 8 * fqi;
#pragma unroll
                for (int bj = 0; bj < 2; ++bj) {
                    f32x4 v0 = acc[ai][bj][m][0] + *(const f32x4*)(bp + bj * 128), v1 = acc[ai][bj][m][1] + *(const f32x4*)(bp + bj * 128 + 4);
                    const int col = (pn & 1) * 256 + bj * 128 + wc * 32 + 8 * fqi;
                    if (pn < 2) { *(u32x4*)(QM + (size_t)r * 512 + col) = pack8(v0, v1); }
                    else if (pn < 4) { v0 = v0 * 0.08838834764831845f; v1 = v1 * 0.08838834764831845f;
                        *(u32x4*)(KM + (size_t)r * 512 + col) = pack8(v0, v1);
                        bf16_t* kt = KT + ((size_t)(r >> 6) * 512 + col) * 64 + (r & 63);
                        kt[0] = f2bf(v0.x); kt[64] = f2bf(v0.y); kt[128] = f2bf(v0.z); kt[192] = f2bf(v0.w); kt[256] = f2bf(v1.x); kt[320] = f2bf(v1.y); kt[384] = f2bf(v1.z); kt[448] = f2bf(v1.w); }
                    else if (pn < 8) { const int vc = (pn - 4) * 256 + bj * 128 + wc * 32 + 8 * fqi;
                        bf16_t* vt = VT + ((size_t)(r >> 6) * 1024 + vc) * 64 + (r & 63);
                        vt[0] = f2bf(v0.x); vt[64] = f2bf(v0.y); vt[128] = f2bf(v0.z); vt[192] = f2bf(v0.w); vt[256] = f2bf(v1.x); vt[320] = f2bf(v1.y); vt[384] = f2bf(v1.z); vt[448] = f2bf(v1.w); }
                    else { const int oc = (pn - 8) * 256 + bj * 128 + wc * 32 + 8 * fqi; *(u32x4*)(OM + (size_t)r * 1024 + oc) = pack8(v0, v1); }
                }
            }
    }
};

struct EpiResid {
    static constexpr bool PERM = true, AFTER_DRAIN = false;
    const float *SL, *SC; const bf16_t* XSs; bf16_t* XB; const float* gate; const float* bias;
    __device__ __forceinline__ void operator()(const f32x4 (&acc)[2][2][4][2], const Unit& u, int wr, int wc, int fr, int fq) const {
        asm volatile("" : "+v"(fr), "+v"(fq));
        const int row0 = u.pm * 256 + wr * 64 + fr, col0 = u.pn * 256 + wc * 32 + 8 * fq;
        f32x4 bv[2][2];
#pragma unroll
        for (int bj = 0; bj < 2; ++bj)
#pragma unroll
            for (int n = 0; n < 2; ++n) bv[bj][n] = *(const f32x4*)(bias + col0 + bj * 128 + 4 * n);
#pragma unroll
        for (int ai = 0; ai < 2; ++ai)
#pragma unroll
            for (int m = 0; m < 4; ++m) { const int r = row0 + ai * 128 + m * 16;
                const float* xs = r < TL ? SL + (size_t)r * D : SC + (size_t)(r - TL) * D;
                const float* g = gate + (size_t)mod_row(r) * NMOD;
#pragma unroll
                for (int bj = 0; bj < 2; ++bj) { const int c = col0 + bj * 128;
                    f32x4 x0, x1;
                    if (XSs) { const u32x4 xw = *(const u32x4*)(XSs + (size_t)r * D + c); x0.x = bflo(xw.x); x0.y = bfhi(xw.x); x0.z = bflo(xw.y); x0.w = bfhi(xw.y); x1.x = bflo(xw.z); x1.y = bfhi(xw.z); x1.z = bflo(xw.w); x1.w = bfhi(xw.w); }
                    else { x0 = *(const f32x4*)(xs + c); x1 = *(const f32x4*)(xs + c + 4); }
                    const f32x4 g0 = *(const f32x4*)(g + c), g1 = *(const f32x4*)(g + c + 4);
                    *(u32x4*)(XB + (size_t)r * D + c) = pack8(x0 * ALPHA + g0 * (acc[ai][bj][m][0] + bv[bj][0]), x1 * ALPHA + g1 * (acc[ai][bj][m][1] + bv[bj][1])); } }
    }
};

struct EpiIn0 {
    static constexpr bool PERM = true, AFTER_DRAIN = false;
    bf16_t *GLU, *Q, *K, *V; const float *biasf, *qg, *kg, *rc, *rs;
    __device__ __forceinline__ void operator()(const f32x4 (&acc)[2][2][4][2], const Unit& u, int wr, int wc, int fr, int fq) const {
        asm volatile("" : "+v"(fr), "+v"(fq));
        const int row0 = u.pm * 256 + wr * 64 + fr, pn = u.pn;
        if (pn < 4) {
#pragma unroll
            for (int ai = 0; ai < 2; ++ai)
#pragma unroll
                for (int m = 0; m < 4; ++m) { const int r = row0 + ai * 128 + m * 16;
                    int fqi = fq; asm volatile("" : "+v"(fqi));
                    const float* bp = biasf + pn * 256 + wc * 32 + 8 * fqi;
                    f32x4 o[2];
#pragma unroll
                    for (int n = 0; n < 2; ++n) { const f32x4 a = acc[ai][0][m][n] + *(const f32x4*)(bp + 4 * n), g = acc[ai][1][m][n] + *(const f32x4*)(bp + 128 + 4 * n);
                        o[n].x = a.x * sigmoidf_(g.x); o[n].y = a.y * sigmoidf_(g.y); o[n].z = a.z * sigmoidf_(g.z); o[n].w = a.w * sigmoidf_(g.w); }
                    *(u32x4*)(GLU + (size_t)r * 512 + pn * 128 + wc * 32 + 8 * fqi) = pack8(o[0], o[1]); }
            return;
        }
        const bool isv = (pn == 6 && wc >= 2);
        const bool isq = (pn < 6);
        const float* gn = isq ? qg : kg;
        const bool lat = u.pm < TL / 256;
#pragma unroll
        for (int ai = 0; ai < 2; ++ai)
#pragma unroll
            for (int m = 0; m < 4; ++m) { const int r = row0 + ai * 128 + m * 16;
                int fqi = fq; asm volatile("" : "+v"(fqi));
                const float* bp = biasf + pn * 256 + wc * 32 + 8 * fqi;
                f32x4 xa[2], xb[2];
#pragma unroll
                for (int n = 0; n < 2; ++n) { xa[n] = acc[ai][0][m][n] + *(const f32x4*)(bp + 4 * n); xb[n] = acc[ai][1][m][n] + *(const f32x4*)(bp + 128 + 4 * n); }
                if (!isv) {
                    float ss = 0.f;
#pragma unroll
                    for (int n = 0; n < 2; ++n) ss += (xa[n].x * xa[n].x + xa[n].y * xa[n].y) + (xa[n].z * xa[n].z + xa[n].w * xa[n].w) + (xb[n].x * xb[n].x + xb[n].y * xb[n].y) + (xb[n].z * xb[n].z + xb[n].w * xb[n].w);
                    ss += xshfl<16>(ss); ss += xshfl<32>(ss);
                    const float rstd = rsqrtf(ss * (1.f / 64.f) + EPS);
#pragma unroll
                    for (int n = 0; n < 2; ++n) { xa[n] = xa[n] * rstd * *(const f32x4*)(gn + 8 * fqi + 4 * n); xb[n] = xb[n] * rstd * *(const f32x4*)(gn + 32 + 8 * fqi + 4 * n); }
                    if (lat) {
                        const int t = r & (SEQ - 1), prow = t >> 6, pcol = t & 63, fi0 = 8 * (fqi & 1);
                        const bool lower = fqi < 2;
#pragma unroll
                        for (int n = 0; n < 2; ++n) {
                            const f32x4 ca = *(const f32x4*)(rc + prow * 16 + fi0 + 4 * n), sa = *(const f32x4*)(rs + prow * 16 + fi0 + 4 * n);
                            const f32x4 cb = *(const f32x4*)(rc + pcol * 16 + fi0 + 4 * n), sb = *(const f32x4*)(rs + pcol * 16 + fi0 + 4 * n);
                            f32x4 oa, ob;
                            oa.x = xshfl<32>(xa[n].x); oa.y = xshfl<32>(xa[n].y); oa.z = xshfl<32>(xa[n].z); oa.w = xshfl<32>(xa[n].w);
                            ob.x = xshfl<32>(xb[n].x); ob.y = xshfl<32>(xb[n].y); ob.z = xshfl<32>(xb[n].z); ob.w = xshfl<32>(xb[n].w);
                            xa[n] = lower ? (xa[n] * ca - oa * sa) : (xa[n] * ca + oa * sa);
                            xb[n] = lower ? (xb[n] * cb - ob * sb) : (xb[n] * cb + ob * sb);
                        }
                    }
                }
                if (isq) {
                    const int head = 4 * (pn - 4) + wc;
                    bf16_t* qp = Q + (size_t)r * 512 + head * 64 + 8 * fqi;
                    *(u32x4*)qp = pack8(xa[0] * QSCALE, xa[1] * QSCALE); *(u32x4*)(qp + 32) = pack8(xb[0] * QSCALE, xb[1] * QSCALE);
                } else {
                    bf16_t* kp = (isv ? V : K) + (size_t)kv_row(r) * 128 + (wc & 1) * 64 + 8 * fqi;
                    *(u32x4*)kp = pack8(xa[0], xa[1]); *(u32x4*)(kp + 32) = pack8(xb[0], xb[1]);
                }
            }
    }
};
}

__host__ __device__ constexpr int bitrev3(int k) { return ((k & 1) << 2) | (k & 2) | ((k >> 2) & 1); }
__host__ __device__ constexpr int bitrev5(int k) { return ((k & 1) << 4) | ((k & 2) << 2) | (k & 4) | ((k & 8) >> 2) | ((k >> 4) & 1); }
__host__ __device__ constexpr int bitrev4(int k) { return ((k & 1) << 3) | ((k & 2) << 1) | ((k & 4) >> 1) | ((k >> 3) & 1); }
template <int N, int MSK, int M> __device__ __forceinline__ void treduce_stepm(float (&d)[M], int lane) {
    const int m = MSK; const bool up = (lane & m) != 0;
#pragma unroll
    for (int i = 0; i < N / 2; ++i) { const float send = up ? d[i] : d[i + N / 2]; const float keep = up ? d[i + N / 2] : d[i]; d[i] = keep + xshfl<MSK>(send); }
}
__device__ __forceinline__ float gelu_erf(float s) { return 0.5f * s * (1.f + erff(s * 0.70710678118654752f)); }

typedef float f32x32v __attribute__((ext_vector_type(32)));
typedef _Float16 h2v __attribute__((ext_vector_type(2)));
typedef _Float16 h32v __attribute__((ext_vector_type(32)));
__device__ __forceinline__ h2v mkh2(float a, float b) { return h2v{(_Float16)a, (_Float16)b}; }
#define HP(R, j) (h2v{(R)[2 * (j)], (R)[2 * (j) + 1]})
typedef unsigned u32x6v __attribute__((ext_vector_type(6)));
typedef unsigned u32x3v __attribute__((ext_vector_type(3)));
__device__ __forceinline__ __amdgpu_buffer_rsrc_t peer_rsrc(const unsigned char* p) {
    const unsigned long long a = (unsigned long long)p;
    const unsigned lo = __builtin_amdgcn_readfirstlane((unsigned)a), hi = __builtin_amdgcn_readfirstlane((unsigned)(a >> 32));
    return __builtin_amdgcn_make_buffer_rsrc((void*)(((unsigned long long)hi << 32) | lo), (short)0, 16384 * ROWB, 0x00020000);
}
template <int ABLP>
__device__ __forceinline__ void peer_apply_phase_t(const Args& A, LAS unsigned char* lds, int wave, int layer, int nrows, bool last, int gw, int NGW, int lane) {
    const bf16_t* HBFr = (const bf16_t*)(A.ws + WS_HBF); bf16_t* HBFw = (bf16_t*)(A.ws + WS_HBF);
    const int* EID = (const int*)(A.ws + WS_EID); const float* GWp = (const float*)(A.ws + WS_GW);
    const unsigned char* UT = A.ws + WS_UT + (size_t)layer * 16384 * ROWB; const unsigned char* VT = A.ws + WS_VT + (size_t)layer * 16384 * ROWB;
    const float* US = (const float*)(A.ws + WS_SC) + (size_t)layer * 16384; const float* VS = (const float*)(A.ws + WS_SC) + (size_t)(2 + layer) * 16384;
    const float* MOD = (const float*)(A.ws + WS_MOD) + (size_t)layer * 9 * NMOD;
    const float* MODN = (const float*)(A.ws + WS_MOD) + (size_t)(layer + 1) * 9 * NMOD;
    const float* gam = SMF(A.ws, SM_LN2G) + layer * D; const float* bet = SMF(A.ws, SM_LN2B) + layer * D;
    const float* GWT = (const float*)(A.ws + WS_MISC + 16384); float* GATE = (float*)(A.ws + WS_GATE);
    const __amdgpu_buffer_rsrc_t rsU = peer_rsrc(UT), rsV = peer_rsrc(VT); const int voff = lane * 12;
    const __amdgpu_buffer_rsrc_t rsG = __builtin_amdgcn_make_buffer_rsrc((void*)GWT, (short)0, 16 * D * 4, 0x00020000);
    float* CB = (float*)(A.ws + WS_CB);
    if (!last) {
        __syncthreads();
        for (int i = wave * 64 + lane; i < 16 * D / 4; i += NTHR) ((LAS f32x4*)lds)[i] = ((const f32x4*)GWT)[i];
        __syncthreads();
    }
    for (int r = gw; r < nrows; r += NGW) {
        int ln = lane; asm volatile("" : "+v"(ln));
        const bf16_t* hrow = HBFr + (size_t)r * D + ln * 4;
        float hf[16];
#pragma unroll
        for (int j = 0; j < 4; ++j) { const u32x2 h2 = *(const u32x2*)(hrow + 256 * j); hf[4 * j] = bflo(h2.x); hf[4 * j + 1] = bfhi(h2.x); hf[4 * j + 2] = bflo(h2.y); hf[4 * j + 3] = bfhi(h2.y); }
        h2v hh[8];
#pragma unroll
        for (int i = 0; i < 8; ++i) hh[i] = mkh2(hf[2 * i], hf[2 * i + 1]);
        const int e0 = EID[(size_t)r * 128 + ln], e1 = EID[(size_t)r * 128 + 64 + ln];
        float c0 = 0.f, c1 = 0.f;
        for (int bt = 0; bt < 4; ++bt) {
            const int ev = bt < 2 ? e0 : e1;
            u32x3v ur[32];
#pragma unroll
            for (int k = 0; k < 32; ++k) { const int id = ABLP == 1 ? k : rl_i(ev, (bt & 1) * 32 + bitrev5(k)); ur[k] = __builtin_bit_cast(u32x3v, __builtin_amdgcn_raw_buffer_load_b96(rsU, voff, id * ROWB, 0)); }
            float d[32];
            if (ABLP == 2) { _Pragma("unroll") for (int k = 0; k < 32; ++k) d[k] = __uint_as_float(ur[k].x ^ ur[k].y ^ ur[k].z); } else
#pragma unroll
            for (int k = 0; k < 32; k += 2) { u32x6v w; w[0] = ur[k].x; w[1] = ur[k].y; w[2] = ur[k].z; w[3] = ur[k + 1].x; w[4] = ur[k + 1].y; w[5] = ur[k + 1].z;
                const h32v R = __builtin_amdgcn_cvt_scalef32_pk32_f16_fp6(w, 1.0f);
                float a0 = 0.f, a1 = 0.f, b0 = 0.f, b1 = 0.f;
#pragma unroll
                for (int i = 0; i < 8; i += 2) { a0 = __builtin_amdgcn_fdot2(HP(R, i), hh[i], a0, false); a1 = __builtin_amdgcn_fdot2(HP(R, i + 1), hh[i + 1], a1, false);
                    b0 = __builtin_amdgcn_fdot2(HP(R, 8 + i), hh[i], b0, false); b1 = __builtin_amdgcn_fdot2(HP(R, 9 + i), hh[i + 1], b1, false); }
                d[k] = a0 + a1; d[k + 1] = b0 + b1; __builtin_amdgcn_sched_barrier(0); }
            treduce_stepm<32, 1>(d, lane); treduce_stepm<16, 2>(d, lane); treduce_stepm<8, 4>(d, lane); treduce_stepm<4, 8>(d, lane); treduce_stepm<2, 16>(d, lane);
            float s = d[0]; s += xshfl<32>(s);
            if ((lane >> 5) == (bt & 1)) { if (bt < 2) c0 = s; else c1 = s; }
        }
        { int lm = lane, ea = e0, eb = e1; asm volatile("" : "+v"(lm), "+v"(ea), "+v"(eb));
          const float g0 = GWp[(size_t)r * 128 + lm], g1 = GWp[(size_t)r * 128 + 64 + lm];
          const float su0 = US[ea], su1 = US[eb], sv0 = VS[ea], sv1 = VS[eb];
          c0 = g0 * gelu_erf(c0 * su0) * sv0; c1 = g1 * gelu_erf(c1 * su1) * sv1;
          CB[(size_t)r * 128 + lm] = c0; CB[(size_t)r * 128 + 64 + lm] = c1; }
    }
    for (int r = gw; r < nrows; r += NGW) {
        int ln = lane; asm volatile("" : "+v"(ln));
        const int e0 = EID[(size_t)r * 128 + ln], e1 = EID[(size_t)r * 128 + 64 + ln];
        const float c0 = CB[(size_t)r * 128 + ln], c1 = CB[(size_t)r * 128 + 64 + ln];
        const unsigned c0h = __builtin_bit_cast(unsigned, mkh2(c0, c0)), c1h = __builtin_bit_cast(unsigned, mkh2(c1, c1));
        float acc[16];
#pragma unroll
        for (int i = 0; i < 16; ++i) acc[i] = 0.f;
        for (int bt = 0; bt < 8; ++bt) {
            const int ev = bt < 4 ? e0 : e1; const unsigned cvh = bt < 4 ? c0h : c1h;
            u32x3v vr[16]; h2v ah[8];
#pragma unroll
            for (int i = 0; i < 8; ++i) ah[i] = mkh2(0.f, 0.f);
#pragma unroll
            for (int k = 0; k < 16; ++k) { const int id = ABLP == 1 ? k : rl_i(ev, (bt & 3) * 16 + k); vr[k] = __builtin_bit_cast(u32x3v, __builtin_amdgcn_raw_buffer_load_b96(rsV, voff, id * ROWB, 0)); }
            if (ABLP == 2) { _Pragma("unroll") for (int k = 0; k < 16; ++k) acc[k] += __uint_as_float(vr[k].x ^ vr[k].y ^ vr[k].z); } else
#pragma unroll
            for (int k = 0; k < 16; k += 2) { const h2v ca = __builtin_bit_cast(h2v, (unsigned)rl_i((int)cvh, (bt & 3) * 16 + k)), cb = __builtin_bit_cast(h2v, (unsigned)rl_i((int)cvh, (bt & 3) * 16 + k + 1));
                u32x6v w; w[0] = vr[k].x; w[1] = vr[k].y; w[2] = vr[k].z; w[3] = vr[k + 1].x; w[4] = vr[k + 1].y; w[5] = vr[k + 1].z;
                const h32v R = __builtin_amdgcn_cvt_scalef32_pk32_f16_fp6(w, 1.0f);
#pragma unroll
                for (int i = 0; i < 8; ++i) { ah[i] = __builtin_elementwise_fma(HP(R, i), ca, ah[i]); ah[i] = __builtin_elementwise_fma(HP(R, 8 + i), cb, ah[i]); }
                __builtin_amdgcn_sched_barrier(0); }
#pragma unroll
            for (int i = 0; i < 8; ++i) { acc[2 * i] += (float)ah[i].x; acc[2 * i + 1] += (float)ah[i].y; }
        }
        int le = lane; asm volatile("" : "+v"(le));
        bf16_t* xsrow = (bf16_t*)(A.ws + WS_XS) + (size_t)r * D + le * 4; float* xrow = A.out + (size_t)(r < TL ? r : 0) * D + le * 4;
        const float* md = MOD + (size_t)mod_row(r) * NMOD + 5 * D + le * 4;
        float v[16]; float s = 0.f;
#pragma unroll
        for (int q = 0; q < 4; ++q) { const u32x2 xw = *(const u32x2*)(xsrow + 256 * q); f32x4 xv; xv.x = bflo(xw.x); xv.y = bfhi(xw.x); xv.z = bflo(xw.y); xv.w = bfhi(xw.y); const f32x4 gv = *(const f32x4*)(md + 256 * q);
            v[4 * q + 0] = ALPHA * xv.x + gv.x * acc[4 * q + 0]; v[4 * q + 1] = ALPHA * xv.y + gv.y * acc[4 * q + 1]; v[4 * q + 2] = ALPHA * xv.z + gv.z * acc[4 * q + 2]; v[4 * q + 3] = ALPHA * xv.w + gv.w * acc[4 * q + 3];
            s += (v[4 * q] + v[4 * q + 1]) + (v[4 * q + 2] + v[4 * q + 3]); }
        float mean = wsum(s) * (1.f / D), s2 = 0.f;
#pragma unroll
        for (int i = 0; i < 16; ++i) { v[i] -= mean; s2 += v[i] * v[i]; }
        float rstd = rsqrtf(wsum(s2) * (1.f / D) + EPS);
        s = 0.f;
#pragma unroll
        for (int q = 0; q < 4; ++q) { const f32x4 gv = *(const f32x4*)(gam + le * 4 + 256 * q), bv = *(const f32x4*)(bet + le * 4 + 256 * q);
            f32x4 y; y.x = v[4 * q] * rstd * gv.x + bv.x; y.y = v[4 * q + 1] * rstd * gv.y + bv.y; y.z = v[4 * q + 2] * rstd * gv.z + bv.z; y.w = v[4 * q + 3] * rstd * gv.w + bv.w;
            if (last) *(f32x4*)(xrow + 256 * q) = y; else { u32x2 w; w.x = pk2(y.x, y.y); w.y = pk2(y.z, y.w); *(u32x2*)(xsrow + 256 * q) = w; }
            v[4 * q] = y.x; v[4 * q + 1] = y.y; v[4 * q + 2] = y.z; v[4 * q + 3] = y.w; s += (y.x + y.y) + (y.z + y.w); }
        if (last) continue;
        mean = wsum(s) * (1.f / D); s2 = 0.f;
#pragma unroll
        for (int i = 0; i < 16; ++i) { v[i] -= mean; s2 += v[i] * v[i]; }
        rstd = rsqrtf(wsum(s2) * (1.f / D) + EPS);
        const float* mdn = MODN + (size_t)mod_row(r) * NMOD + le * 4;
        unsigned hw[8];
#pragma unroll
        for (int q = 0; q < 4; ++q) { const f32x4 sh = *(const f32x4*)(mdn + 256 * q), sc = *(const f32x4*)(mdn + D + 256 * q);
            const float y0 = v[4 * q] * rstd * (1.f + sc.x) + sh.x, y1 = v[4 * q + 1] * rstd * (1.f + sc.y) + sh.y, y2 = v[4 * q + 2] * rstd * (1.f + sc.z) + sh.z, y3 = v[4 * q + 3] * rstd * (1.f + sc.w) + sh.w;
            hw[2 * q] = pk2(y0, y1); hw[2 * q + 1] = pk2(y2, y3); }
        bf16_t* ho = HBFw + (size_t)r * D + le * 4;
#pragma unroll
        for (int q = 0; q < 4; ++q) { u32x2 w; w.x = hw[2 * q]; w.y = hw[2 * q + 1]; *(u32x2*)(ho + 256 * q) = w; }
        float gp[16];
#pragma unroll
        for (int jg = 0; jg < 16; ++jg) { float a = 0.f;
#pragma unroll
            for (int q = 0; q < 4; ++q) { const f32x4 wv = *(const LAS f32x4*)(lds + (jg * D + 256 * q) * 4 + le * 16);
                a += bflo(hw[2 * q]) * wv.x + bfhi(hw[2 * q]) * wv.y + bflo(hw[2 * q + 1]) * wv.z + bfhi(hw[2 * q + 1]) * wv.w; }
            gp[jg] = a; }
        treduce_stepm<16, 1>(gp, lane); treduce_stepm<8, 2>(gp, lane); treduce_stepm<4, 4>(gp, lane); treduce_stepm<2, 8>(gp, lane);
        float gs = gp[0]; gs += xshfl<16>(gs); gs += xshfl<32>(gs);
        if (le < 16) { const int jg = bitrev4(le); GATE[(size_t)r * 16 + jg] = gs + SMF(A.ws, SM_MLBIN)[3072 + jg]; }
    }
}

__device__ __forceinline__ void peer_apply_phase(const Args& A, LAS unsigned char* lds, int wave, int layer, int nrows, bool last, int gw, int NGW, int lane) { peer_apply_phase_t<0>(A, lds, wave, layer, nrows, last, gw, NGW, lane); }
#undef MK_HAVE_P3
#define MK_HAVE_P3 1
#include <hip/hip_bf16.h>
#include <cmath>
namespace attn_body {
using bf16=__hip_bfloat16;
using bf16x8=__attribute__((ext_vector_type(8)))short;
using s16x4=__attribute__((ext_vector_type(4)))short;
using f32x16=__attribute__((ext_vector_type(16)))float;
using u32x4=__attribute__((ext_vector_type(4)))unsigned;
constexpr int D=64,QPITCH=512,KVPITCH=128,OPITCH=1024;
constexpr int NW=8,QBLK=32,QB=QBLK*NW,KVBLK=64;
__device__ __forceinline__ int crow(int r,int hi){return (r&3)+8*(r>>2)+4*hi;}
#define SBAR() __builtin_amdgcn_sched_barrier(0)
constexpr int NSLOT=3, SLOTB=8192;
constexpr int LDS_K=0, LDS_V=NSLOT*SLOTB, LDS_WS=2*NSLOT*SLOTB, LDS_OST=LDS_WS+NW*64*4, LDS_BYTES=LDS_OST+NW*4096;
constexpr float C2=0.125f*1.4426950408889634f;
__device__ __forceinline__ void glds16(const void*gsrc,unsigned lds_dst){unsigned keep;
  asm volatile("s_mov_b32 %0, m0\n\ts_mov_b32 m0, %2\n\ts_nop 0\n\tglobal_load_lds_dwordx4 %1, off\n\ts_mov_b32 m0, %0":"=&s"(keep):"v"(gsrc),"s"(lds_dst):"memory");}
__device__ __forceinline__ float max3f(float a,float b,float c){float r;asm("v_max3_f32 %0, %1, %2, %3":"=v"(r):"v"(a),"v"(b),"v"(c));return r;}
__device__ __forceinline__ float max2f(float a,float b){float r;asm("v_max_f32_e32 %0, %1, %2":"=v"(r):"v"(a),"v"(b));return r;}
__device__ __forceinline__ float fadd_s(float a,float b){float r;asm("v_add_f32_e32 %0, %1, %2":"=v"(r):"v"(a),"v"(b));return r;}
__device__ __forceinline__ float fsub_s(float a,float b){float r;asm("v_sub_f32_e32 %0, %1, %2":"=v"(r):"v"(a),"v"(b));return r;}
typedef float f32x2_t __attribute__((ext_vector_type(2))); typedef __bf16 bf16x2_t __attribute__((ext_vector_type(2)));
__device__ __forceinline__ unsigned cvtpk_s(float lo,float hi){f32x2_t v={lo,hi};bf16x2_t b=__builtin_convertvector(v,bf16x2_t);return __builtin_bit_cast(unsigned,b);}
#define WAIT_BAR(N) asm volatile("s_waitcnt vmcnt(" #N ") lgkmcnt(0)\n\ts_barrier":::"memory")

__device__ __forceinline__ void qkt(f32x16&p0,f32x16&p1,const char*Kslot,const bf16x8*qr,const f32x16&negm,int r32,int hi){
  const char*kb=Kslot+hi*1024+r32*16;
  #pragma unroll
  for(int d0=0;d0<4;++d0){
    const bf16x8 b0=*reinterpret_cast<const bf16x8*>(kb+d0*2048);
    const bf16x8 b1=*reinterpret_cast<const bf16x8*>(kb+d0*2048+512);
    if(d0==0){p0=__builtin_amdgcn_mfma_f32_32x32x16_bf16(b0,qr[0],negm,0,0,0);p1=__builtin_amdgcn_mfma_f32_32x32x16_bf16(b1,qr[0],negm,0,0,0);}
    else{p0=__builtin_amdgcn_mfma_f32_32x32x16_bf16(b0,qr[d0],p0,0,0,0);p1=__builtin_amdgcn_mfma_f32_32x32x16_bf16(b1,qr[d0],p1,0,0,0);}}
}
typedef __attribute__((address_space(3))) const char* lds_cptr;
typedef short v4i16_t __attribute__((ext_vector_type(4)));
__device__ __forceinline__ void kload8(bf16x8*kf,lds_cptr kp){
  kf[0]=*(const __attribute__((address_space(3))) bf16x8*)(kp);      kf[1]=*(const __attribute__((address_space(3))) bf16x8*)(kp+512);
  kf[2]=*(const __attribute__((address_space(3))) bf16x8*)(kp+2048); kf[3]=*(const __attribute__((address_space(3))) bf16x8*)(kp+2560);
  kf[4]=*(const __attribute__((address_space(3))) bf16x8*)(kp+4096); kf[5]=*(const __attribute__((address_space(3))) bf16x8*)(kp+4608);
  kf[6]=*(const __attribute__((address_space(3))) bf16x8*)(kp+6144); kf[7]=*(const __attribute__((address_space(3))) bf16x8*)(kp+6656);
}
__device__ __forceinline__ void kload2(bf16x8*kf,lds_cptr kp,int j){ kf[2*j]=*(const __attribute__((address_space(3))) bf16x8*)(kp+j*2048); kf[2*j+1]=*(const __attribute__((address_space(3))) bf16x8*)(kp+j*2048+512); }
__device__ __forceinline__ s16x4 vtr(lds_cptr p){ return __builtin_bit_cast(s16x4,__builtin_amdgcn_ds_read_tr16_b64_v4i16((__attribute__((address_space(3))) v4i16_t*)p)); }
__device__ __forceinline__ float rowmax(const f32x16&p0,const f32x16&p1){
  float a=max3f(p0[0],p0[1],p1[0]),b=max3f(p0[2],p0[3],p1[1]);a=max3f(a,p1[2],p1[3]);
  #pragma unroll
  for(int r=4;r<16;r+=4){a=max3f(a,p0[r],p0[r+1]);b=max3f(b,p0[r+2],p0[r+3]);a=max3f(a,p1[r],p1[r+1]);b=max3f(b,p1[r+2],p1[r+3]);}
  const float m=max2f(a,b);
  auto rr=__builtin_amdgcn_permlane32_swap(__float_as_uint(m),__float_as_uint(m),false,false);
  return max2f(__uint_as_float(rr[0]),__uint_as_float(rr[1]));
}
__device__ __forceinline__ void pv(f32x16*o,int vb,bf16x8 pa0,bf16x8 pa1,bf16x8 pa2,bf16x8 pa3){
  #pragma unroll
  for(int d0=0;d0<2;++d0){s16x4 lo[4],hi[4];
    #pragma unroll
    for(int ks=0;ks<4;++ks){
      asm volatile("ds_read_b64_tr_b16 %0,%1 offset:%c2":"=&v"(lo[ks]):"v"(vb),"i"(d0*4096+ks*1024):"memory");
      asm volatile("ds_read_b64_tr_b16 %0,%1 offset:%c2":"=&v"(hi[ks]):"v"(vb),"i"(d0*4096+ks*1024+512):"memory");}
    asm volatile("s_waitcnt lgkmcnt(0)":::"memory");SBAR();
    #define PK(k) (bf16x8){lo[k][0],lo[k][1],lo[k][2],lo[k][3],hi[k][0],hi[k][1],hi[k][2],hi[k][3]}
    o[d0]=__builtin_amdgcn_mfma_f32_32x32x16_bf16(pa0,PK(0),o[d0],0,0,0);
    o[d0]=__builtin_amdgcn_mfma_f32_32x32x16_bf16(pa1,PK(1),o[d0],0,0,0);
    o[d0]=__builtin_amdgcn_mfma_f32_32x32x16_bf16(pa2,PK(2),o[d0],0,0,0);
    o[d0]=__builtin_amdgcn_mfma_f32_32x32x16_bf16(pa3,PK(3),o[d0],0,0,0);
    #undef PK
  }
}
#ifndef ATTN_STORE16
#define ATTN_STORE16(p,v) (*(u32x4*)(p)=(v))
#endif
template<int THRL> __device__ __forceinline__ void attn_unit(const bf16*Qu,const bf16*__restrict__ Kh,const bf16*__restrict__ Vh,bf16*Ou,const int NT,char*shm,const int wid){
  const int lane=fresh_lane(),r32=lane&31,hi=lane>>5;
  const bf16*Qw=Qu+(long)(wid*QBLK)*QPITCH;
  const unsigned lds0=(unsigned)(uintptr_t)shm;
  float*wsf=(float*)(shm+LDS_WS)+wid*64;
  const bf16*ksrc=Kh+(long)lane*KVPITCH+wid*8;
  const bf16*vsrc=Vh+(long)(16*(wid&3)+(lane>>2))*KVPITCH+(wid>>2)*32+(lane&3)*8;
  const unsigned kdst=lds0+LDS_K+wid*1024, vdst=lds0+LDS_V+wid*1024;
  #define DMA_K(t,slot) glds16(ksrc+(long)(t)*KVBLK*KVPITCH,(unsigned)__builtin_amdgcn_readfirstlane(kdst+(slot)))
  #define DMA_V(t,slot) glds16(vsrc+(long)(t)*KVBLK*KVPITCH,(unsigned)__builtin_amdgcn_readfirstlane(vdst+(slot)))
  const int vb0=(int)(lds0+LDS_V)+((lane>>4)&1)*32+(lane&3)*8+(4*hi+((lane&15)>>2))*64;
  const char*Kbase=shm+LDS_K; bf16x8 kf[8];
  const lds_cptr shm3=(lds_cptr)shm; const lds_cptr kp0=shm3+LDS_K+hi*1024+r32*16; const lds_cptr vp0=shm3+LDS_V+((lane>>4)&1)*32+(lane&3)*8+(4*hi+((lane&15)>>2))*64;
  DMA_K(0,0);DMA_V(0,0);DMA_K(1,SLOTB);
  bf16x8 qr[4];
  #pragma unroll
  for(int d0=0;d0<4;++d0)qr[d0]=*reinterpret_cast<const bf16x8*>(&Qw[(long)r32*QPITCH+d0*16+hi*8]);
  float mhat=0.f,l_reg=0.f;f32x16 o[2];o[0]=f32x16{};o[1]=f32x16{};f32x16 negm=f32x16{};asm volatile("":"+v"(negm));
  #define CMASK(P0,P1,t) do{}while(0)
  bool resc=false;
  #define START(P0,P1) do{ const float rm=rowmax(P0,P1); resc=false; \
    { const float dl=rm; mhat=fadd_s(mhat,dl); \
      _Pragma("unroll") for(int r=0;r<16;++r){P0[r]=fsub_s(P0[r],dl);P1[r]=fsub_s(P1[r],dl);} \
      _Pragma("unroll") for(int r=0;r<16;++r)negm[r]=-mhat; asm volatile("":"+v"(negm)); } \
    _Pragma("unroll") for(int r=0;r<16;++r)P0[r]=__builtin_amdgcn_exp2f(P0[r]); }while(0)
  #define RESC() do{ if(resc){ asm volatile("s_waitcnt lgkmcnt(0)":::"memory"); \
      _Pragma("unroll") for(int d_=0;d_<2;++d_) _Pragma("unroll") for(int r=0;r<16;++r)o[d_][r]*=wsf[crow(r,hi)]; } }while(0)
  f32x16 pA0,pA1,pB0,pB1;
  int sl_prev=0,sl_cur=0,sl_next=SLOTB;
  #define ROT() do{sl_prev=sl_cur;sl_cur=sl_next;sl_next=(sl_next==(NSLOT-1)*SLOTB)?0:sl_next+SLOTB;}while(0)
  DMA_K(2,2*SLOTB);
  WAIT_BAR(3);
  qkt(pA0,pA1,Kbase,qr,negm,r32,hi);asm volatile("s_nop 15\n\ts_nop 7":"+v"(pA0),"+v"(pA1));CMASK(pA0,pA1,0);
  START(pA0,pA1);
  _Pragma("unroll") for(int r=0;r<16;++r)pA1[r]=__builtin_amdgcn_exp2f(pA1[r]);
  WAIT_BAR(0);
  DMA_K(3,0);DMA_V(1,SLOTB);
  ROT();
  kload8(kf,kp0+sl_cur);
  WAIT_BAR(2);
  s16x4 vlo[8],vhi[8]; u32x4 pw0,pw1,pw2,pw3;
  #define PKW(P,B) cvtpk_s(P[B],P[B+1])
  #define PAF(k) __builtin_bit_cast(bf16x8,pw##k)
  #define VFR(i) (bf16x8){vlo[i][0],vlo[i][1],vlo[i][2],vlo[i][3],vhi[i][0],vhi[i][1],vhi[i][2],vhi[i][3]}
  #define PIN(x) asm volatile("":"+v"(x))
  #define MX3(a,b,c) __builtin_fmaxf(__builtin_fmaxf((a),(b)),(c))
  #define GAPA(MF,A0,A1,A2,A3,W0,W1,PW) do{ MF; sacc+=A0; sacc+=A1; sacc+=A2; sacc+=A3; PIN(sacc); W0; W1; PIN(PW); SBAR(); }while(0)
  #define EX(v) __builtin_amdgcn_exp2f(v)
  #define GAPB(MF,X,B) do{ MF; X[B]=EX(X[B]); X[B+1]=EX(X[B+1]); X[B+2]=EX(X[B+2]); X[B+3]=EX(X[B+3]); PIN(X); SBAR(); }while(0)
  #define VRD(i) do{ vlo[i]=vtr(vp_+(((i)>>2)*4096+((i)&3)*1024)); vhi[i]=vtr(vp_+(((i)>>2)*4096+((i)&3)*1024+512)); }while(0)
  #define KRD(G,j) do{ if(G){ kload2(kf,kp0+sl_next,j); SBAR(); } }while(0)
  #define STEP(C0,C1,P0,P1,t,GK,GV,GL) do{ SBAR(); \
    const lds_cptr vp_=vp0+sl_prev; \
    VRD(0); SBAR(); float sacc=(P0[0]+P0[1]); \
    GAPA(C0=__builtin_amdgcn_mfma_f32_32x32x16_bf16(kf[0],qr[0],negm,0,0,0), P0[2],P0[3],P0[4],P0[5],     pw0[0]=PKW(P0,0), pw0[1]=PKW(P0,2), pw0); \
    VRD(4); SBAR(); GAPA(C1=__builtin_amdgcn_mfma_f32_32x32x16_bf16(kf[1],qr[0],negm,0,0,0), P0[6],P0[7],P0[8],P0[9],     pw0[2]=PKW(P0,4), pw0[3]=PKW(P0,6), pw0); \
    VRD(1); SBAR(); GAPA(C0=__builtin_amdgcn_mfma_f32_32x32x16_bf16(kf[2],qr[1],C0,0,0,0),   P0[10],P0[11],P0[12],P0[13], pw1[0]=PKW(P0,8), pw1[1]=PKW(P0,10), pw1); \
    VRD(5); SBAR(); GAPA(C1=__builtin_amdgcn_mfma_f32_32x32x16_bf16(kf[3],qr[1],C1,0,0,0),   P0[14],P0[15],P1[0],P1[1],   pw1[2]=PKW(P0,12),pw1[3]=PKW(P0,14), pw1); \
    VRD(2); SBAR(); GAPA(C0=__builtin_amdgcn_mfma_f32_32x32x16_bf16(kf[4],qr[2],C0,0,0,0),   P1[2],P1[3],P1[4],P1[5],     pw2[0]=PKW(P1,0), pw2[1]=PKW(P1,2), pw2); \
    VRD(6); SBAR(); GAPA(C1=__builtin_amdgcn_mfma_f32_32x32x16_bf16(kf[5],qr[2],C1,0,0,0),   P1[6],P1[7],P1[8],P1[9],     pw2[2]=PKW(P1,4), pw2[3]=PKW(P1,6), pw2); \
    VRD(3); SBAR(); GAPA(C0=__builtin_amdgcn_mfma_f32_32x32x16_bf16(kf[6],qr[3],C0,0,0,0),   P1[10],P1[11],P1[12],P1[13], pw3[0]=PKW(P1,8), pw3[1]=PKW(P1,10), pw3); \
    VRD(7); SBAR(); GAPA(C1=__builtin_amdgcn_mfma_f32_32x32x16_bf16(kf[7],qr[3],C1,0,0,0),   P1[14],P1[15],0.f,0.f,       pw3[2]=PKW(P1,12),pw3[3]=PKW(P1,14), pw3); \
    l_reg+=sacc; \
    if(GK){DMA_K((t)+3,sl_cur);} if(GV){DMA_V((t)+1,sl_next);} \
    CMASK(C0,C1,t); \
    { float a=MX3(C0[0],C0[1],C1[0]),b=MX3(C0[2],C0[3],C1[1]); a=MX3(a,C1[2],C1[3]); \
      _Pragma("unroll") for(int r=4;r<16;r+=4){a=MX3(a,C0[r],C0[r+1]);b=MX3(b,C0[r+2],C0[r+3]);a=MX3(a,C1[r],C1[r+1]);b=MX3(b,C1[r+2],C1[r+3]);} \
      float rm=__builtin_fmaxf(a,b); { auto rr=__builtin_amdgcn_permlane32_swap(__float_as_uint(rm),__float_as_uint(rm),false,false); rm=__builtin_fmaxf(__uint_as_float(rr[0]),__uint_as_float(rr[1])); } \
      resc=false; \
      if(__builtin_expect(__any(rm>(float)THRL),0)){ const float dl=__builtin_fmaxf(rm,0.f); mhat+=dl; \
        _Pragma("unroll") for(int r=0;r<16;++r){C0[r]-=dl;C1[r]-=dl;} \
        _Pragma("unroll") for(int r=0;r<16;++r)negm[r]=-mhat; asm volatile("":"+v"(negm)); \
        const float f=__builtin_amdgcn_exp2f(-dl); l_reg*=f; if(hi==0)wsf[r32]=f; resc=true; } } \
    SBAR(); \
    GAPB(o[0]=__builtin_amdgcn_mfma_f32_32x32x16_bf16(PAF(0),VFR(0),o[0],0,0,0), C0,0); \
    GAPB(o[1]=__builtin_amdgcn_mfma_f32_32x32x16_bf16(PAF(0),VFR(4),o[1],0,0,0), C0,4); \
    KRD(GL,0); GAPB(o[0]=__builtin_amdgcn_mfma_f32_32x32x16_bf16(PAF(1),VFR(1),o[0],0,0,0), C0,8); \
    KRD(GL,1); GAPB(o[1]=__builtin_amdgcn_mfma_f32_32x32x16_bf16(PAF(1),VFR(5),o[1],0,0,0), C0,12); \
    KRD(GL,2); GAPB(o[0]=__builtin_amdgcn_mfma_f32_32x32x16_bf16(PAF(2),VFR(2),o[0],0,0,0), C1,0); \
    KRD(GL,3); GAPB(o[1]=__builtin_amdgcn_mfma_f32_32x32x16_bf16(PAF(2),VFR(6),o[1],0,0,0), C1,4); \
    GAPB(o[0]=__builtin_amdgcn_mfma_f32_32x32x16_bf16(PAF(3),VFR(3),o[0],0,0,0), C1,8); \
    GAPB(o[1]=__builtin_amdgcn_mfma_f32_32x32x16_bf16(PAF(3),VFR(7),o[1],0,0,0), C1,12); \
    }while(0)
  int t=1;
  #undef CMASK
  #define CMASK(P0,P1,t) do{}while(0)
  for(;t+5<NT;t+=2){
    STEP(pB0,pB1,pA0,pA1,t,true,true,true);     WAIT_BAR(2); RESC(); ROT();
    STEP(pA0,pA1,pB0,pB1,t+1,true,true,true);   WAIT_BAR(2); RESC(); ROT();
  }
  #undef CMASK
  #define CMASK(P0,P1,t) do{}while(0)
  #define ENDW(tt) do{ if((tt)+3<NT){WAIT_BAR(2);} else if((tt)+2<NT){WAIT_BAR(1);} else {WAIT_BAR(0);} }while(0)
  for(;t+1<NT;t+=2){
    STEP(pB0,pB1,pA0,pA1,t,(t+3<NT),(t+1<NT),(t+1<NT));       ENDW(t);   RESC(); ROT();
    STEP(pA0,pA1,pB0,pB1,t+1,(t+4<NT),(t+2<NT),(t+2<NT));     ENDW(t+1); RESC(); ROT();
  }
  STEP(pB0,pB1,pA0,pA1,NT-1,false,false,false); RESC();
  { float sacc=pB0[0]+pB0[1]; _Pragma("unroll") for(int r=2;r<16;++r)sacc+=pB0[r]; _Pragma("unroll") for(int r=0;r<16;++r)sacc+=pB1[r]; l_reg+=sacc;
    pw0=(u32x4){PKW(pB0,0),PKW(pB0,2),PKW(pB0,4),PKW(pB0,6)};pw1=(u32x4){PKW(pB0,8),PKW(pB0,10),PKW(pB0,12),PKW(pB0,14)};pw2=(u32x4){PKW(pB1,0),PKW(pB1,2),PKW(pB1,4),PKW(pB1,6)};pw3=(u32x4){PKW(pB1,8),PKW(pB1,10),PKW(pB1,12),PKW(pB1,14)};
    SBAR(); pv(o,vb0+sl_cur,PAF(0),PAF(1),PAF(2),PAF(3)); }
  #undef PKW
  #undef PAF
  #undef VFR
  #undef PIN
  #undef MX3
  #undef GAPA
  #undef GAPB
  #undef EX
  #undef VRD
  #undef KRD
  #undef STEP
  #undef ENDW
  {auto rr=__builtin_amdgcn_permlane32_swap(__float_as_uint(l_reg),__float_as_uint(l_reg),false,false);l_reg=__uint_as_float(rr[0])+__uint_as_float(rr[1]);}
  if(hi==0)wsf[32+r32]=l_reg;asm volatile("s_waitcnt lgkmcnt(0)":::"memory");
  float rli[16];
  #pragma unroll
  for(int r=0;r<16;++r)rli[r]=__builtin_amdgcn_rcpf(wsf[32+crow(r,hi)]);
  bf16*Ow=Ou+(long)(wid*QBLK)*OPITCH;
  { bf16*stg=(bf16*)(shm+LDS_OST)+wid*2048;
    #pragma unroll
    for(int r=0;r<16;++r){const int orow=crow(r,hi);
      #pragma unroll
      for(int d0=0;d0<2;++d0)stg[orow*64+d0*32+r32]=__float2bfloat16(o[d0][r]*rli[r]);}
    asm volatile("s_waitcnt lgkmcnt(0)":::"memory");
    #pragma unroll
    for(int i=0;i<4;++i){const int row=i*8+(lane>>3),ch=lane&7; const u32x4 v=*(const u32x4*)(stg+row*64+ch*8); ATTN_STORE16(Ow+(long)row*OPITCH+ch*8,v);} }
  asm volatile("s_waitcnt lgkmcnt(0)\n\ts_barrier":::"memory");
  #undef DMA_K
  #undef DMA_V
  #undef CMASK
  #undef START
  #undef RESC
  #undef ROT
}
constexpr int ATTN_LDS_BYTES=LDS_BYTES;
#undef SBAR
#undef WAIT_BAR
}

template <int ABL3>
__device__ __forceinline__ void p3_attn_conv_t(const Args& A, unsigned char* lds_raw, int vcu, int G, int wave) {
    typedef attn_body::bf16 abf;
    const abf* Q = (const abf*)(A.ws + WS_Q); const abf* K = (const abf*)(A.ws + WS_K); const abf* V = (const abf*)(A.ws + WS_V); abf* Y = (abf*)(A.ws + WS_YBF);
    if (ABL3 != 1) for (int u = vcu; u < 576; u += G) {
        const abf *Qu, *Kh, *Vh; abf* Ou; int NT;
        if (u < 512) { const int b = u >> 6, h = (u >> 3) & 7, qb = u & 7; const size_t row = (size_t)b * SEQ + qb * 256;
            Qu = Q + row * 512 + h * 64; Ou = Y + row * 1024 + 512 + h * 64; Kh = K + (size_t)b * KVLEN * 128 + (h >> 2) * 64; Vh = V + (size_t)b * KVLEN * 128 + (h >> 2) * 64; NT = KVLEN / 64; }
        else { const int uu = u - 512, b = uu >> 3, h = uu & 7; const size_t row = (size_t)TL + b * CTX;
            Qu = Q + row * 512 + h * 64; Ou = Y + row * 1024 + 512 + h * 64; Kh = K + (size_t)b * KVLEN * 128 + (h >> 2) * 64; Vh = V + (size_t)b * KVLEN * 128 + (h >> 2) * 64; NT = CTX / 64; }
        attn_body::attn_unit<8>(Qu, Kh, Vh, Ou, NT, (char*)lds_raw, wave);
    }
    LAS unsigned char* lds = (LAS unsigned char*)lds_raw;
    const int lane = fresh_lane(), tid = wave * 64 + lane;
    const bf16_t* GLU = (const bf16_t*)(A.ws + WS_GLU); bf16_t* YB = (bf16_t*)(A.ws + WS_YBF);
    constexpr int CW_OFF = 0, CX_OFF = 32768, SUB = 18;
    __syncthreads();
    if (ABL3 != 2) { u32x4 wv[4];
#pragma unroll
        for (int it = 0; it < 4; ++it) wv[it] = ((const u32x4*)(A.ws + WS_MISC + SM_W2))[tid + it * NTHR];
#pragma unroll
        for (int it = 0; it < 4; ++it) ((LAS u32x4*)(lds + CW_OFF))[tid + it * NTHR] = wv[it]; }
    const int rows_per = (TT + G - 1) / G, r0 = vcu * rows_per, r1 = (r0 + rows_per < TT) ? r0 + rows_per : TT;
    if (ABL3 != 2) for (int s0 = r0; s0 < r1; s0 += SUB) {
        const int s1 = (s0 + SUB < r1) ? s0 + SUB : r1, base = s0 - 15, nst = (s1 - s0) + 29;
        __syncthreads();
        { u32x4 xa[6], xb[6];
#pragma unroll
          for (int it = 0; it < 6; ++it) { const int i = tid + it * NTHR, rr = base + (i >> 6), ch = i & 63; xa[it] = u32x4{0u, 0u, 0u, 0u}; xb[it] = u32x4{0u, 0u, 0u, 0u};
              if (i < nst * 64) { if (rr >= 0 && rr < TT) xa[it] = *(const u32x4*)(GLU + (size_t)rr * 512 + ch * 8);
                                  if (rr + 1 >= 0 && rr + 1 < TT) xb[it] = *(const u32x4*)(GLU + (size_t)(rr + 1) * 512 + ch * 8); } }
#pragma unroll
          for (int it = 0; it < 6; ++it) { const int i = tid + it * NTHR, ch = i & 63;
              if (i < nst * 64) { u32x4 o0, o1;
                  o0.x = (xa[it].x & 0xffffu) | (xb[it].x << 16); o0.y = (xa[it].x >> 16) | (xb[it].x & 0xffff0000u); o0.z = (xa[it].y & 0xffffu) | (xb[it].y << 16); o0.w = (xa[it].y >> 16) | (xb[it].y & 0xffff0000u);
                  o1.x = (xa[it].z & 0xffffu) | (xb[it].z << 16); o1.y = (xa[it].z >> 16) | (xb[it].z & 0xffff0000u); o1.z = (xa[it].w & 0xffffu) | (xb[it].w << 16); o1.w = (xa[it].w >> 16) | (xb[it].w & 0xffff0000u);
                  LAS u32x4* dst = (LAS u32x4*)(lds + CX_OFF + (i >> 6) * 2048 + ch * 32); dst[0] = o0; dst[1] = o1; } } }
        __syncthreads();
        for (int r = s0 + wave; r < s1; r += NWAVES) {
            int lo, hi; if (r < TL) { lo = r & ~(SEQ - 1); hi = lo + SEQ; } else { lo = TL + ((r - TL) & ~(CTX - 1)); hi = lo + CTX; }
            float acc[8];
            { const f32x4 b0 = *(const f32x4*)(SMF(A.ws, SM_CONVB) + lane * 8), b1 = *(const f32x4*)(SMF(A.ws, SM_CONVB) + lane * 8 + 4);
              acc[0] = b0.x; acc[1] = b0.y; acc[2] = b0.z; acc[3] = b0.w; acc[4] = b1.x; acc[5] = b1.y; acc[6] = b1.z; acc[7] = b1.w; }
#pragma unroll 4
            for (int jp = 0; jp < 16; ++jp) { const int rr = r + 2 * jp - 15;
                const bool v0 = rr >= lo && rr < hi, v1 = rr + 1 >= lo && rr + 1 < hi;
                if (!v0 && !v1) continue;
                const unsigned wm = (v0 ? 0x0000ffffu : 0u) | (v1 ? 0xffff0000u : 0u);
                const LAS u32x4* xp = (const LAS u32x4*)(lds + CX_OFF + (rr - base) * 2048 + lane * 32); const LAS u32x4* wp = (const LAS u32x4*)(lds + CW_OFF + jp * 2048 + lane * 32);
                const u32x4 x0 = xp[0], x1 = xp[1], w0 = wp[0], w1 = wp[1];
                acc[0] = dot2bf(x0.x, w0.x & wm, acc[0]); acc[1] = dot2bf(x0.y, w0.y & wm, acc[1]); acc[2] = dot2bf(x0.z, w0.z & wm, acc[2]); acc[3] = dot2bf(x0.w, w0.w & wm, acc[3]);
                acc[4] = dot2bf(x1.x, w1.x & wm, acc[4]); acc[5] = dot2bf(x1.y, w1.y & wm, acc[5]); acc[6] = dot2bf(x1.z, w1.z & wm, acc[6]); acc[7] = dot2bf(x1.w, w1.w & wm, acc[7]); }
            float s = 0.f;
#pragma unroll
            for (int i = 0; i < 8; ++i) s += acc[i];
            const float mu = wsum(s) * (1.f / 512.f); float s2 = 0.f;
#pragma unroll
            for (int i = 0; i < 8; ++i) { acc[i] -= mu; s2 += acc[i] * acc[i]; }
            const float rstd = rsqrtf(wsum(s2) * (1.f / 512.f) + EPS);
            const f32x4 g0 = *(const f32x4*)(SMF(A.ws, SM_CLNG) + lane * 8), g1 = *(const f32x4*)(SMF(A.ws, SM_CLNG) + lane * 8 + 4), c0 = *(const f32x4*)(SMF(A.ws, SM_CLNB) + lane * 8), c1 = *(const f32x4*)(SMF(A.ws, SM_CLNB) + lane * 8 + 4);
            float y[8];
            y[0] = acc[0] * rstd * g0.x + c0.x; y[1] = acc[1] * rstd * g0.y + c0.y; y[2] = acc[2] * rstd * g0.z + c0.z; y[3] = acc[3] * rstd * g0.w + c0.w;
            y[4] = acc[4] * rstd * g1.x + c1.x; y[5] = acc[5] * rstd * g1.y + c1.y; y[6] = acc[6] * rstd * g1.z + c1.z; y[7] = acc[7] * rstd * g1.w + c1.w;
#pragma unroll
            for (int i = 0; i < 8; ++i) y[i] = y[i] * sigmoidf_(y[i]);
            u32x4 o; o.x = pk2(y[0], y[1]); o.y = pk2(y[2], y[3]); o.z = pk2(y[4], y[5]); o.w = pk2(y[6], y[7]);
            *(u32x4*)(YB + (size_t)r * D + lane * 8) = o;
        }
    }
    __syncthreads();
}

__device__ __forceinline__ void p3_attn_conv(const Args& A, unsigned char* lds_raw, int vcu, int G, int wave) { p3_attn_conv_t<0>(A, lds_raw, vcu, G, wave); }
#undef MK_HAVE_P7
#define MK_HAVE_P7 1
namespace topk {
typedef short bf16x8 __attribute__((ext_vector_type(8)));
typedef float f32x16 __attribute__((ext_vector_type(16)));
constexpr int KROW = 272;
constexpr int LDS_K1 = 0, LDS_K2 = 128 * KROW, LDS_TAB = 2 * 128 * KROW, LDS_IDX = LDS_TAB + 256;
__device__ __forceinline__ int f2key(float f, int idx, int mask) { int b = (__float_as_int(f) & ~mask) | idx; return b ^ ((b >> 31) & 0x7fffffff); }
__device__ __forceinline__ int key2bits(int k) { return k ^ ((k >> 31) & 0x7fffffff); }
__device__ __forceinline__ void ce_desc(int& a, int& b) { const int hi = a > b ? a : b, lo = a > b ? b : a; a = hi; b = lo; }
template <int N> __device__ __forceinline__ void bitonic_sort_desc(int (&v)[N]) {
#pragma unroll
    for (int k = 2; k <= N; k <<= 1)
#pragma unroll
        for (int j = k >> 1; j > 0; j >>= 1)
#pragma unroll
            for (int i = 0; i < N; ++i) { const int l = i ^ j; if (l > i) { if ((i & k) == 0) ce_desc(v[i], v[l]); else ce_desc(v[l], v[i]); } }
}
template <int N> __device__ __forceinline__ void bitonic_merge_desc(int (&v)[N]) {
#pragma unroll
    for (int j = N >> 1; j > 0; j >>= 1)
#pragma unroll
        for (int i = 0; i < N; ++i) { const int l = i ^ j; if (l > i) ce_desc(v[i], v[l]); }
}
__device__ __forceinline__ void merge_top16(int (&a)[16], const int (&b)[16]) {
#pragma unroll
    for (int i = 0; i < 16; ++i) a[i] = a[i] > b[15 - i] ? a[i] : b[15 - i];
    bitonic_merge_desc<16>(a);
}
__device__ __forceinline__ void top16_of_64(int (&g0)[16], int (&g1)[16], int (&g2)[16], int (&g3)[16]) {
    bitonic_sort_desc<16>(g0); bitonic_sort_desc<16>(g1); bitonic_sort_desc<16>(g2); bitonic_sort_desc<16>(g3);
    merge_top16(g0, g1); merge_top16(g2, g3); merge_top16(g0, g2);
}
__host__ __device__ constexpr int cand_a(int li) {
    int cnt = 0;
    for (int a = 0; a < 16; ++a) for (int b = 0; b < 16; ++b) if ((a + 1) * (b + 1) <= 16) { if (cnt == li) return a; ++cnt; }
    return 0;
}
__host__ __device__ constexpr int cand_b(int li) {
    int cnt = 0;
    for (int a = 0; a < 16; ++a) for (int b = 0; b < 16; ++b) if ((a + 1) * (b + 1) <= 16) { if (cnt == li) return b; ++cnt; }
    return 0;
}
template <int I> struct CandFill {
    static __device__ __forceinline__ void run(int (&c)[32], const float (&v1)[16], const float (&v2)[16], bool hi) {
        constexpr int lo_i = I, hi_i = 32 + I, hi_c = hi_i < 50 ? hi_i : 0;
        constexpr int alo = cand_a(lo_i), blo = cand_b(lo_i), ahi = cand_a(hi_c), bhi = cand_b(hi_c);
        const float slo = v1[alo] + v2[blo];
        const float shi = hi_i < 50 ? v1[ahi] + v2[bhi] : -INFINITY;
        c[I] = f2key(hi ? shi : slo, hi ? hi_i : lo_i, 63);
        CandFill<I + 1>::run(c, v1, v2, hi);
    }
};
template <> struct CandFill<32> { static __device__ __forceinline__ void run(int (&)[32], const float (&)[16], const float (&)[16], bool) {} };

__device__ __forceinline__ void p7_topk(const Args& A, LAS unsigned char* lds, int layer, int nrows, int vcu, int G, int wave) {
    const int lane = fresh_lane(), tid = wave * 64 + lane, tok = lane & 31, hi = lane >> 5;
    const bf16_t* QP = (const bf16_t*)(A.ws + WS_QP);
    const bf16_t* K12 = (const bf16_t*)(A.ws + WS_K12) + (size_t)layer * 2 * 131072;
    int* EID = (int*)(A.ws + WS_EID); float* GWo = (float*)(A.ws + WS_GW);
    if (tid < 64) { int a = 0, b = 0, cnt = 0; for (int aa = 0; aa < 16; ++aa) for (int bb = 0; bb < 16; ++bb) if ((aa + 1) * (bb + 1) <= 16) { if (cnt == tid) { a = aa; b = bb; } ++cnt; }
        lds[LDS_TAB + 2 * tid] = (unsigned char)a; lds[LDS_TAB + 2 * tid + 1] = (unsigned char)b; }
    const int nunits = (nrows / 256) * 8;
    int staged_h = -1;
    bf16x8 bqA[8], bqB[8];
#define TOPK_LOADQ(DST, U, HALF) do { const int h_ = (U) & 7, t0_ = ((U) >> 3) * 256 + wave * 32; const bf16_t* qrow_ = QP + (size_t)(t0_ + tok) * 2048 + h_ * 256 + (HALF) * 128 + 8 * hi; \
        _Pragma("unroll") for (int ks = 0; ks < 8; ++ks) DST[ks] = *(const bf16x8*)(qrow_ + 16 * ks); } while (0)
    if (vcu < nunits) TOPK_LOADQ(bqA, vcu, 0);
    for (int u = vcu; u < nunits; u += G) {
        const int h = u & 7, tile = u >> 3;
        if (h != staged_h) {
            __syncthreads();
            for (int i = tid; i < 2 * 2048; i += NTHR) { const int which = i >> 11, c = i & 2047, row = c >> 4, ch = c & 15;
                const u32x4 v = *(const u32x4*)(K12 + (size_t)which * 131072 + (size_t)h * 16384 + row * 128 + ch * 8);
                *(LAS u32x4*)(lds + (which ? LDS_K2 : LDS_K1) + row * KROW + ch * 16) = v; }
            __syncthreads();
            staged_h = h;
        }
        const int t0 = tile * 256 + wave * 32;
        int L1[16], L2[16];
#pragma unroll
        for (int half = 0; half < 2; ++half) {
            if (half == 0) TOPK_LOADQ(bqB, u, 1); else if (u + G < nunits) TOPK_LOADQ(bqA, u + G, 0);
            f32x16 acc[4];
#pragma unroll
            for (int kb = 0; kb < 4; ++kb) { acc[kb] = f32x16{};
                const LAS unsigned char* kp = lds + (half ? LDS_K2 : LDS_K1) + (kb * 32 + tok) * KROW + 16 * hi;
#pragma unroll
                for (int ks = 0; ks < 8; ++ks) { const bf16x8 a = *(const LAS bf16x8*)(kp + 32 * ks); acc[kb] = __builtin_amdgcn_mfma_f32_32x32x16_bf16(a, half ? bqB[ks] : bqA[ks], acc[kb], 0, 0, 0); } }
            int g0[16], g1[16], g2[16], g3[16];
#pragma unroll
            for (int r = 0; r < 16; ++r) { const int kr = (r & 3) + 8 * (r >> 2) + 4 * hi;
                g0[r] = f2key(acc[0][r], kr, 127); g1[r] = f2key(acc[1][r], 32 + kr, 127); g2[r] = f2key(acc[2][r], 64 + kr, 127); g3[r] = f2key(acc[3][r], 96 + kr, 127); }
            top16_of_64(g0, g1, g2, g3);
#pragma unroll
            for (int i = 0; i < 16; ++i) { if (half == 0) L1[i] = g0[i]; else L2[i] = g0[i]; }
        }
        int Wm[16], Wo[16];
#pragma unroll
        for (int i = 0; i < 16; ++i) { auto rr = __builtin_amdgcn_permlane32_swap((unsigned)L1[i], (unsigned)L2[i], false, false); Wm[i] = (int)rr[0]; Wo[i] = (int)rr[1]; }
        merge_top16(Wm, Wo);
        float v1[16], v2[16]; int i1[16], i2[16];
#pragma unroll
        for (int i = 0; i < 16; ++i) { auto rr = __builtin_amdgcn_permlane32_swap((unsigned)Wm[i], (unsigned)Wm[i], false, false);
            const int b1 = key2bits((int)rr[0]), b2 = key2bits((int)rr[1]); v1[i] = __int_as_float(b1); v2[i] = __int_as_float(b2); i1[i] = b1 & 127; i2[i] = b2 & 127; }
        { u32x4 w;
          w.x = (hi ? i2[0] : i1[0]) | ((hi ? i2[1] : i1[1]) << 8) | ((hi ? i2[2] : i1[2]) << 16) | ((hi ? i2[3] : i1[3]) << 24);
          w.y = (hi ? i2[4] : i1[4]) | ((hi ? i2[5] : i1[5]) << 8) | ((hi ? i2[6] : i1[6]) << 16) | ((hi ? i2[7] : i1[7]) << 24);
          w.z = (hi ? i2[8] : i1[8]) | ((hi ? i2[9] : i1[9]) << 8) | ((hi ? i2[10] : i1[10]) << 16) | ((hi ? i2[11] : i1[11]) << 24);
          w.w = (hi ? i2[12] : i1[12]) | ((hi ? i2[13] : i1[13]) << 8) | ((hi ? i2[14] : i1[14]) << 16) | ((hi ? i2[15] : i1[15]) << 24);
          *(LAS u32x4*)(lds + LDS_IDX + wave * 1024 + tok * 32 + hi * 16) = w; }
        int c[32];
        CandFill<0>::run(c, v1, v2, hi != 0);
        int ca[16], cb[16];
#pragma unroll
        for (int i = 0; i < 16; ++i) { ca[i] = c[i]; cb[i] = c[16 + i]; }
        bitonic_sort_desc<16>(ca); bitonic_sort_desc<16>(cb); merge_top16(ca, cb);
        int T[16];
#pragma unroll
        for (int i = 0; i < 16; ++i) { auto rr = __builtin_amdgcn_permlane32_swap((unsigned)ca[i], (unsigned)ca[i], false, false); T[i] = (int)rr[0]; cb[i] = (int)rr[1]; }
#pragma unroll
        for (int i = 0; i < 16; ++i) T[i] = T[i] > cb[15 - i] ? T[i] : cb[15 - i];
        float sv[16]; float mx = -INFINITY;
#pragma unroll
        for (int i = 0; i < 16; ++i) { sv[i] = __int_as_float(key2bits(T[i])); mx = fmaxf(mx, sv[i]); }
        float sum = 0.f;
#pragma unroll
        for (int i = 0; i < 16; ++i) { sv[i] = __expf(sv[i] - mx); sum += sv[i]; }
        const float inv = 1.f / sum;
        LDS_WAIT(); asm volatile("" ::: "memory");
        int eo[8]; float go[8];
#pragma unroll
        for (int i = 0; i < 8; ++i) { const int kk = hi ? T[8 + i] : T[i]; const int li = key2bits(kk) & 63;
            const int a = lds[LDS_TAB + 2 * li], b = lds[LDS_TAB + 2 * li + 1];
            const int k1i = lds[LDS_IDX + wave * 1024 + tok * 32 + a], k2i = lds[LDS_IDX + wave * 1024 + tok * 32 + 16 + b];
            eo[i] = k1i * 128 + k2i; go[i] = (hi ? sv[8 + i] : sv[i]) * inv; }
        int* ep = EID + (size_t)(t0 + tok) * 128 + h * 16 + hi * 8; float* gp = GWo + (size_t)(t0 + tok) * 128 + h * 16 + hi * 8;
        { typedef int i32x4 __attribute__((ext_vector_type(4))); i32x4 e0v = {eo[0], eo[1], eo[2], eo[3]}, e1v = {eo[4], eo[5], eo[6], eo[7]}; *(i32x4*)ep = e0v; *(i32x4*)(ep + 4) = e1v;
          f32x4 g0v = {go[0], go[1], go[2], go[3]}, g1v = {go[4], go[5], go[6], go[7]}; *(f32x4*)gp = g0v; *(f32x4*)(gp + 4) = g1v; }
    }
#undef TOPK_LOADQ
    __syncthreads();
}
}
using topk::p7_topk;
#undef MK_HAVE_P10
#define MK_HAVE_P10 1
namespace mls {
typedef short bf16x8 __attribute__((ext_vector_type(8)));
typedef float f32x16 __attribute__((ext_vector_type(16)));
constexpr int S272 = 272, S144 = 144;
constexpr int L_GB = 0, L_GBETA = 9216, L_GPM = 18432;
constexpr int L_Q = 27648, L_K = L_Q + 64 * S272, L_KWT = L_K + 64 * S272;
constexpr int L_VT = L_KWT + 128 * S144, L_SP = L_VT + 96 * S144;
constexpr int L_CB = L_SP + 64 * S144;
constexpr int L_NS = L_CB + 96 * S272, L_DEN = L_NS + 512, L_QN = L_DEN + 512, L_END = L_QN + 256;
static_assert(L_END <= RING_BYTES, "mlstm LDS map");
__device__ __forceinline__ int crow(int r, int hi) { return (r & 3) + 8 * (r >> 2) + 4 * hi; }
__device__ __forceinline__ float logsig(float x) { return fminf(x, 0.f) - log1pf(__expf(-fabsf(x))); }
template <int NK> __device__ __forceinline__ f32x16 mfma_chain(LAS unsigned char* lds, int aoff, int boff, f32x16 acc) {
    bf16x8 fa[NK], fb[NK];
#pragma unroll
    for (int ks = 0; ks < NK; ++ks) { fa[ks] = *(const LAS bf16x8*)(lds + aoff + 32 * ks); fb[ks] = *(const LAS bf16x8*)(lds + boff + 32 * ks); }
    __builtin_amdgcn_sched_barrier(0);
#pragma unroll
    for (int ks = 0; ks < NK; ++ks) acc = __builtin_amdgcn_mfma_f32_32x32x16_bf16(fa[ks], fb[ks], acc, 0, 0, 0);
    return acc;
}
#define LDS_BAR() do { if (ABL != 5) asm volatile("s_waitcnt lgkmcnt(0)\n\ts_barrier" ::: "memory"); } while (0)
#define EX2(x) __builtin_amdgcn_exp2f(x)
#define MFMA32(a, b, c) __builtin_amdgcn_mfma_f32_32x32x16_bf16(a, b, c, 0, 0, 0)
#define LDB8(off) (*(const LAS bf16x8*)(lds + (off)))

template <int ABL>
__device__ __forceinline__ void p10_mlstm_t(const Args& A, LAS unsigned char* lds, int vcu, int G, int wave) {
    const int lane = fresh_lane(), tid = wave * 64 + lane, r32 = lane & 31, hi = lane >> 5;
    const bf16_t* QM = (const bf16_t*)(A.ws + WS_QM); const bf16_t* KM = (const bf16_t*)(A.ws + WS_KM); const bf16_t* KT = (const bf16_t*)(A.ws + WS_KT); const bf16_t* VT = (const bf16_t*)(A.ws + WS_VM);
    const float* GT = (const float*)(A.ws + WS_GATE);
    for (int u = vcu; u < 256; u += G) {
        const int sl = u & 3, hd = (u >> 2) & 3, dir = (u >> 4) & 1, b = u >> 5;
        bf16_t* HO = (bf16_t*)(A.ws + (dir ? WS_YBF : WS_HBF));
        __syncthreads();
        for (int i = tid; i < (L_END - L_Q) / 4; i += NTHR) ((LAS unsigned*)(lds + L_Q))[i] = 0u;
        __syncthreads();
        if (tid < 32) ((LAS unsigned*)(lds + L_VT + 64 * S144))[tid] = 0x3F803F80u;
#define CHUNK(step) ((step) < 4 ? (TL + b * CTX) / 64 + (dir ? 3 - (step) : (step)) : (b * SEQ) / 64 + (dir ? 35 - (step) : (step) - 4))
        for (int step = wave; step < 36; step += NWAVES) {
            const int p = dir ? 63 - lane : lane;
            const size_t row = (size_t)CHUNK(step) * 64 + p;
            const float gi = GT[row * 16 + (dir * 2) * 4 + hd], gf = GT[row * 16 + (dir * 2 + 1) * 4 + hd];
            float bsum = logsig(gf) * 1.4426950408889634f;
#pragma unroll
            for (int o = 1; o < 64; o <<= 1) { const float t = __shfl_up(bsum, o); if (lane >= o) bsum += t; }
            const float beta = gi * 1.4426950408889634f - bsum; float pm = beta;
#pragma unroll
            for (int o = 1; o < 64; o <<= 1) { const float t = __shfl_up(pm, o); if (lane >= o) pm = fmaxf(pm, t); }
            ((LAS float*)(lds + L_GB))[step * 64 + p] = bsum; ((LAS float*)(lds + L_GBETA))[step * 64 + p] = beta; ((LAS float*)(lds + L_GPM))[step * 64 + p] = pm;
        }
        const int plast = dir ? 0 : 63;
        u32x4 rq[2][2], rk[2][2], rkt[2][2], rv[2];
#define LOADSTEP(step, P) do { const size_t cg_ = (size_t)CHUNK(step); \
            _Pragma("unroll") for (int i_ = 0; i_ < 2; ++i_) { const int c_ = tid + 512 * i_; const size_t row_ = cg_ * 64 + (c_ >> 4); \
                rq[P][i_] = *(const u32x4*)(QM + row_ * 512 + hd * 128 + (c_ & 15) * 8); rk[P][i_] = *(const u32x4*)(KM + row_ * 512 + hd * 128 + (c_ & 15) * 8); \
                rkt[P][i_] = *(const u32x4*)(KT + ((cg_ * 512 + hd * 128 + (c_ >> 3)) * 64) + (c_ & 7) * 8); } \
            rv[P] = *(const u32x4*)(VT + ((cg_ * 1024 + hd * 256 + sl * 64 + (tid >> 3)) * 64) + (tid & 7) * 8); } while (0)
        LOADSTEP(0, 0); LOADSTEP(1, 1);
        f32x16 accCn = f32x16{};
        f32x16 accC = f32x16{};
        float m = 0.f;
        __syncthreads();
        for (int step2 = 0; step2 < 36; step2 += 2) {
#pragma unroll
          for (int par = 0; par < 2; ++par) {
            const int step = step2 + par;
            const LAS float* gb = (const LAS float*)(lds + L_GB) + step * 64; const LAS float* gbeta = (const LAS float*)(lds + L_GBETA) + step * 64; const LAS float* gpm = (const LAS float*)(lds + L_GPM) + step * 64;
            const float Mlast = fmaxf(m, gpm[plast]), dc = EX2(m - Mlast);
#pragma unroll
            for (int i = 0; i < 2; ++i) { const int c = tid + 512 * i;
                *(LAS u32x4*)(lds + L_Q + (c >> 4) * S272 + (c & 15) * 16) = rq[par][i]; *(LAS u32x4*)(lds + L_K + (c >> 4) * S272 + (c & 15) * 16) = rk[par][i];
                const int s0 = (c & 7) * 8; const f32x4 b0 = *(const LAS f32x4*)(gbeta + s0), b1 = *(const LAS f32x4*)(gbeta + s0 + 4);
                u32x4 o;
                if (ABL == 6) { o = rkt[par][i]; } else {
                o.x = pk2(bflo(rkt[par][i].x) * EX2(b0.x - Mlast), bfhi(rkt[par][i].x) * EX2(b0.y - Mlast)); o.y = pk2(bflo(rkt[par][i].y) * EX2(b0.z - Mlast), bfhi(rkt[par][i].y) * EX2(b0.w - Mlast));
                o.z = pk2(bflo(rkt[par][i].z) * EX2(b1.x - Mlast), bfhi(rkt[par][i].z) * EX2(b1.y - Mlast)); o.w = pk2(bflo(rkt[par][i].w) * EX2(b1.z - Mlast), bfhi(rkt[par][i].w) * EX2(b1.w - Mlast)); }
                *(LAS u32x4*)(lds + L_KWT + (c >> 3) * S144 + (c & 7) * 16) = o; }
            *(LAS u32x4*)(lds + L_VT + (tid >> 3) * S144 + (tid & 7) * 16) = rv[par];
            if (ABL != 4) LOADSTEP((step + 2 < 36 ? step + 2 : 35), par);
            LDS_BAR();
            f32x16 accN = f32x16{};
            if (ABL == 7) { LDS_BAR(); LDS_BAR(); m = gb[plast] + Mlast; continue; }
            if (wave < 4) { if (ABL != 9) {
                const int vb = wave & 1, tb = wave >> 1;
accN = mfma_chain<8>(lds, L_CB + (vb * 32 + r32) * S272 + 16 * hi, L_Q + (tb * 32 + r32) * S272 + 16 * hi, accN);
                const float aw = EX2(m - fmaxf(m, gpm[tb * 32 + r32]));
#pragma unroll
                for (int r = 0; r < 16; ++r) accN[r] *= aw; }
            } else if (wave < 7) { if (ABL != 8) {
                const int sb = wave == 4 ? 0 : (wave == 6 ? 1 : dir), tb = wave == 4 ? 0 : (wave == 6 ? 1 : 1 - dir);
                f32x16 accS = f32x16{};
accS = mfma_chain<8>(lds, L_K + (sb * 32 + r32) * S272 + 16 * hi, L_Q + (tb * 32 + r32) * S272 + 16 * hi, accS);
                const int t = tb * 32 + r32; const float Mt = fmaxf(m, gpm[t]);
                float rs = 0.f;
#pragma unroll
                for (int g = 0; g < 4; ++g) { float pv[4];
#pragma unroll
                    for (int q = 0; q < 4; ++q) { const int s = sb * 32 + 8 * g + 4 * hi + q; const bool ok = (sb != tb) || (dir ? (s >= t) : (s <= t)); const float w = ABL == 3 ? 0.5f : (ok ? EX2(gbeta[s] - Mt) : 0.f); pv[q] = accS[4 * g + q] * w; rs += pv[q]; }
                    u32x2 o; o.x = pk2(pv[0], pv[1]); o.y = pk2(pv[2], pv[3]);
                    *(LAS u32x2*)(lds + L_SP + t * S144 + (sb * 32 + 8 * g + 4 * hi) * 2) = o; }
                rs += xshfl<32>(rs);
                if (hi == 0) ((LAS float*)(lds + L_DEN))[sb * 64 + t] = rs; }
            } else if (ABL != 1) {
#pragma unroll
                for (int tb = 0; tb < 2; ++tb) { f32x16 aq = f32x16{};
aq = mfma_chain<8>(lds, L_CB + (64 + r32) * S272 + 16 * hi, L_Q + (tb * 32 + r32) * S272 + 16 * hi, aq);
                    if (hi == 0) ((LAS float*)(lds + L_QN))[tb * 32 + r32] = aq[0]; }
            }
            { const int vb = wave & 1, db = wave >> 1;
#pragma unroll
              for (int r = 0; r < 16; ++r) accC[r] *= dc;
accC = mfma_chain<4>(lds, L_KWT + (db * 32 + r32) * S144 + 16 * hi, L_VT + (vb * 32 + r32) * S144 + 16 * hi, accC); }
            if (wave < 4) {
#pragma unroll
              for (int r = 0; r < 16; ++r) accCn[r] *= dc;
accCn = mfma_chain<4>(lds, L_KWT + (wave * 32 + r32) * S144 + 16 * hi, L_VT + (64 + r32) * S144 + 16 * hi, accCn); }
            LDS_BAR();
            if (wave < 4 && ABL != 10) {
                const int vb = wave & 1, tb = wave >> 1, t = tb * 32 + r32;
accN = mfma_chain<4>(lds, L_VT + (vb * 32 + r32) * S144 + 16 * hi, L_SP + (tb * 32 + r32) * S144 + 16 * hi, accN);
                if (step >= 4) {
                    const float Mt = fmaxf(m, gpm[t]), aw = EX2(m - Mt);
                    const float den = ((const LAS float*)(lds + L_DEN))[t] + ((const LAS float*)(lds + L_DEN))[64 + t] + aw * ((const LAS float*)(lds + L_QN))[t];
                    const float inv = 1.f / fmaxf(fabsf(den), EX2(-(gb[t] + Mt)));
                    bf16_t* hp = HO + ((size_t)CHUNK(step) * 64 + t) * D + hd * 256 + sl * 64 + vb * 32 + 4 * hi;
#pragma unroll
                    for (int g = 0; g < 4; ++g) { u32x2 o; o.x = pk2(accN[4 * g] * inv, accN[4 * g + 1] * inv); o.y = pk2(accN[4 * g + 2] * inv, accN[4 * g + 3] * inv); *(u32x2*)(hp + 8 * g) = o; }
                }
            }
            { const int vb = wave & 1, db = wave >> 1;
#pragma unroll
              for (int g = 0; g < 4; ++g) { u32x2 o; o.x = pk2(accC[4 * g], accC[4 * g + 1]); o.y = pk2(accC[4 * g + 2], accC[4 * g + 3]);
                  *(LAS u32x2*)(lds + L_CB + (vb * 32 + r32) * S272 + (db * 32 + 8 * g + 4 * hi) * 2) = o; } }
            if (wave < 4) {
#pragma unroll
              for (int g = 0; g < 4; ++g) { u32x2 o; o.x = pk2(accCn[4 * g], accCn[4 * g + 1]); o.y = pk2(accCn[4 * g + 2], accCn[4 * g + 3]);
                  *(LAS u32x2*)(lds + L_CB + (64 + r32) * S272 + (wave * 32 + 8 * g + 4 * hi) * 2) = o; } }
            m = gb[plast] + Mlast;
            LDS_BAR();
          }
        }
#undef LOADSTEP
#undef CHUNK
    }
    __syncthreads();
}
#undef EX2
#undef MFMA32
#undef LDB8

__device__ __forceinline__ void p11_finish(const Args& A, int gw, int NGW, int lane) {
    const bf16_t* HF = (const bf16_t*)(A.ws + WS_HBF); bf16_t* HB = (bf16_t*)(A.ws + WS_YBF); const bf16_t* OM = (const bf16_t*)(A.ws + WS_OM); const float* ng = SMF(A.ws, SM_MLNG);
    for (int r = gw; r < TL; r += NGW) {
        const size_t base = (size_t)r * D + lane * 4;
#pragma unroll
        for (int j = 0; j < 4; ++j) {
            const u32x2 a = *(const u32x2*)(HF + base + 256 * j), c = *(const u32x2*)(HB + base + 256 * j), o = *(const u32x2*)(OM + base + 256 * j);
            float v[4] = {bflo(a.x) + bflo(c.x), bfhi(a.x) + bfhi(c.x), bflo(a.y) + bflo(c.y), bfhi(a.y) + bfhi(c.y)};
            const float mu = wsum((v[0] + v[1]) + (v[2] + v[3])) * (1.f / 256.f);
#pragma unroll
            for (int i = 0; i < 4; ++i) v[i] -= mu;
            const float rstd = rsqrtf(wsum((v[0] * v[0] + v[1] * v[1]) + (v[2] * v[2] + v[3] * v[3])) * (1.f / 256.f) + EPS);
            const f32x4 g = *(const f32x4*)(ng + 256 * j + lane * 4);
            u32x2 w; w.x = pk2(v[0] * rstd * g.x * sigmoidf_(bflo(o.x)), v[1] * rstd * g.y * sigmoidf_(bfhi(o.x))); w.y = pk2(v[2] * rstd * g.z * sigmoidf_(bflo(o.y)), v[3] * rstd * g.w * sigmoidf_(bfhi(o.y)));
            *(u32x2*)(HB + base + 256 * j) = w;
        }
    }
}
}
__device__ __forceinline__ void p10_mlstm(const Args& A, LAS unsigned char* lds, int vcu, int G, int wave) { mls::p10_mlstm_t<0>(A, lds, vcu, G, wave); }
using mls::p11_finish;
#ifndef MK_HAVE_P3
#define MK_HAVE_P3 0
#endif
#ifndef MK_HAVE_P7
#define MK_HAVE_P7 0
#endif
#ifndef MK_HAVE_P10
#define MK_HAVE_P10 0
#endif
#ifndef MK_ALL
#define MK_ALL 0
#endif
constexpr int NPHASE = 17;
__device__ __forceinline__ int opaque_s(int x) { x = __builtin_amdgcn_readfirstlane(x); asm volatile("" : "+s"(x)); return x; }
#if MK_ALL
#define IN(k) true
#else
#define IN(k) (A.ph_lo <= (k) && (k) < A.ph_hi)
#endif
#define SEAM(k) do { if (IN(k) && IN((k) + 1)) xcd_barrier(bar, WV()); } while (0)
#define WV() opaque_s(wave)
#define TID() (WV() * 64 + fresh_lane())
template <int L>
__device__ __forceinline__ void layer_phases(const Args& A, LAS unsigned char* lds, unsigned char* lds_raw, const XcdBarrier& bar, const int wave, const int vcu, const int gw, const int NGW, const int G, const int bx) {
    unsigned char* ws = A.ws;
    bf16_t* HBF = (bf16_t*)(ws + WS_HBF); bf16_t* YBF = (bf16_t*)(ws + WS_YBF);
    float* XC = (float*)(ws + WS_XC); float* XL = A.out;
    const float* MOD0 = (const float*)(ws + WS_MOD);
    constexpr int nrows = L ? TL : TT;
    if constexpr (L == 0) {
        if (IN(2)) {
            pg8::Gemm g{HBF, (const bf16_t*)(ws + WS_WIN0), TT, AB_IN, D}; pg8::StaticOrder S; S.init(TT, AB_IN, G, opaque_s(bx));
            epi::EpiIn0 E{(bf16_t*)(ws + WS_GLU), (bf16_t*)(ws + WS_Q), (bf16_t*)(ws + WS_K), (bf16_t*)(ws + WS_V), (const float*)(ws + WS_MISC), SMF(ws, SM_QNG), SMF(ws, SM_KNG),
                          (const float*)(ws + WS_MISC + 8192), (const float*)(ws + WS_MISC + 12288)};
            pg8::gemm_phase<epi::EpiIn0, pg8::StaticOrder, true, true>(lds, g, S, E, WV());
        }
        SEAM(2);
#if MK_HAVE_P3
        if (IN(3)) p3_attn_conv(A, lds_raw, opaque_s(vcu), G, WV());
#endif
        SEAM(3);
    } else {
        if (IN(9)) {
            pg8::Gemm g{HBF, (const bf16_t*)(ws + WS_WIN1), TT, 3072, D}; pg8::StaticOrder S; S.init(TT, 3072, G, opaque_s(bx));
            epi::EpiIn1 E{(bf16_t*)(ws + WS_QM), (bf16_t*)(ws + WS_KM), (bf16_t*)(ws + WS_KT), (bf16_t*)(ws + WS_VM), (bf16_t*)(ws + WS_OM), SMF(ws, SM_MLBIN)};
            pg8::gemm_phase<epi::EpiIn1, pg8::StaticOrder, true, true>(lds, g, S, E, WV());
        }
        SEAM(9);
#if MK_HAVE_P10
        if (IN(10)) p10_mlstm(A, lds, opaque_s(vcu), G, WV());
        SEAM(10);
        if (IN(11)) p11_finish(A, opaque_s(gw), NGW, fresh_lane());
#else
        SEAM(10);
#endif
        SEAM(11);
    }
    constexpr int pb = L ? 12 : 4;
    if (IN(pb)) {
        pg8::Gemm g{YBF, (const bf16_t*)(ws + (L ? WS_WOUT1 : WS_WOUT0)), nrows, D, D}; pg8::StaticOrder S; S.init(nrows, D, G, opaque_s(bx));
        epi::EpiResid E{A.in[I_X], A.in[I_CTX], L ? (const bf16_t*)(ws + WS_XS) : (const bf16_t*)nullptr, (bf16_t*)(ws + WS_XB), MOD0 + (size_t)L * 9 * NMOD + 2 * D, L ? SMF(ws, SM_MLBOUT) : SMF(ws, SM_ABBOUT)};
        pg8::gemm_phase<epi::EpiResid, pg8::StaticOrder, true, true>(lds, g, S, E, WV());
    }
    SEAM(pb);
    if (IN(pb + 1)) p5_ln_ln_mod(A, L, nrows, opaque_s(gw), NGW, fresh_lane());
    SEAM(pb + 1);
    if (IN(pb + 2)) {
        pg8::Gemm g{HBF, (const bf16_t*)(ws + (L ? WS_WQ1 : WS_WQ0)), nrows, 2048, D}; pg8::StaticOrder S; S.init(nrows, 2048, G, opaque_s(bx));
        epi::EpiPlain E{(bf16_t*)(ws + WS_QP), 2048};
        pg8::gemm_phase<epi::EpiPlain, pg8::StaticOrder, true, true>(lds, g, S, E, WV());
    }
    SEAM(pb + 2);
#if MK_HAVE_P7
    if (IN(pb + 3)) p7_topk(A, lds, L, nrows, opaque_s(vcu), G, WV());
#endif
    SEAM(pb + 3);
    if (IN(pb + 4)) peer_apply_phase(A, lds, WV(), L, nrows, L == 1, opaque_s(gw), NGW, fresh_lane());
    if constexpr (L == 0) SEAM(8);
}
__global__ void __launch_bounds__(NTHR, 2) mk_fwd(Args A) {
    extern __shared__ __attribute__((aligned(16))) unsigned char lds_raw[];
    LAS unsigned char* lds = (LAS unsigned char*)lds_raw;
    const int wave = __builtin_amdgcn_readfirstlane(threadIdx.x >> 6);
    const int G = gridDim.x, bx = blockIdx.x;
    const int vcu = (G % 8 == 0) ? (bx % 8) * (G / 8) + bx / 8 : bx;
    const int gw = vcu * NWAVES + wave, NGW = G * NWAVES;
    { const int t0 = wave * 64 + fresh_lane(); for (int u = t0; u < (LDS_BYTES - LDSCTL_OFF) / 4; u += NTHR) ((LAS unsigned*)(lds + LDSCTL_OFF))[u] = 0u; }
    __syncthreads();
    XcdBarrier bar = xcd_barrier_post((unsigned*)(A.ws + WS_CTL) + CW_BAR, (volatile LAS unsigned*)(lds + MISC_OFF) + 8, wave);
    if (IN(0)) p0_prologue(A, lds, opaque_s(vcu), G, TID());
    SEAM(0);
    if (IN(1)) p1_ln_mod(A, opaque_s(gw), NGW, fresh_lane());
    SEAM(1);
    layer_phases<0>(A, lds, lds_raw, bar, wave, vcu, gw, NGW, G, bx);
    layer_phases<1>(A, lds, lds_raw, bar, wave, vcu, gw, NGW, G, bx);
#ifdef PROBE_ABLP
    if (IN(24)) peer_apply_phase_t<PROBE_ABLP>(A, lds, WV(), 0, TT, true, opaque_s(gw), NGW, fresh_lane());
    if (IN(22)) peer_apply_phase_t<PROBE_ABLP>(A, lds, WV(), 1, TL, true, opaque_s(gw), NGW, fresh_lane());
#endif
#ifdef PROBE_ABL3
    if (IN(21)) p3_attn_conv_t<PROBE_ABL3>(A, lds_raw, opaque_s(vcu), G, WV());
#endif
#ifdef PROBE_ABL
    if (IN(20)) mls::p10_mlstm_t<PROBE_ABL>(A, lds, opaque_s(vcu), G, WV());
#endif
}
#undef IN
#undef SEAM
#undef TID
#undef WV

static int g_grid = 0;
static void mk_launch(const Args& base, int lo, int hi, hipStream_t stream) {
    Args a = base; a.ph_lo = lo; a.ph_hi = hi;
    (void)hipMemsetAsync(a.ws + WS_CTL, 0, CTL_ZERO_BYTES, stream);
    void* params[] = {&a};
#ifdef PLAIN_LAUNCH
    hipError_t e = hipLaunchKernel((const void*)mk_fwd, dim3(g_grid), dim3(NTHR), params, LDS_BYTES, stream);
#else
    hipError_t e = hipLaunchCooperativeKernel((const void*)mk_fwd, dim3(g_grid), dim3(NTHR), params, LDS_BYTES, stream);
#endif
    if (e != hipSuccess) fprintf(stderr, "mk_launch [%d,%d): cooperative launch failed: %s (grid %d)\n", lo, hi, hipGetErrorString(e), g_grid);
}

#ifndef MK_A
#define MK_A 1
#endif
#ifndef MK_B
#define MK_B 0
#endif
#ifndef MK_C
#define MK_C 1
#endif
#ifndef MK_D
#define MK_D 0
#endif
#ifndef MK_E
#define MK_E 1
#endif
#ifndef MK_F
#define MK_F 1
#endif
#ifndef MK_G
#define MK_G 0
#endif
#ifndef MK_H
#define MK_H 1
#endif
#ifndef MK_I
#define MK_I 0
#endif
#ifndef MK_J
#define MK_J 1
#endif

extern "C" void kernel_launch(void* const* d_in, const int* in_sizes, int n_in, void* d_out, int out_size, void* d_ws, size_t ws_size, hipStream_t stream) {
    if (n_in != 30 || ws_size < WS_END2 || out_size != TL * D) { fprintf(stderr, "kernel_launch: unexpected n_in %d / ws %zu / out %d\n", n_in, ws_size, out_size); return; }
    if (g_grid == 0) {
        int dev = 0, cus = 0, per_cu = 0;
        (void)hipGetDevice(&dev); (void)hipDeviceGetAttribute(&cus, hipDeviceAttributeMultiprocessorCount, dev);
        (void)hipFuncSetAttribute((const void*)mk_fwd, hipFuncAttributeMaxDynamicSharedMemorySize, LDS_BYTES);
        (void)hipOccupancyMaxActiveBlocksPerMultiprocessor(&per_cu, (const void*)mk_fwd, NTHR, LDS_BYTES);
        if (per_cu < 1) { fprintf(stderr, "kernel_launch: occupancy query says %d blocks/CU\n", per_cu); per_cu = 1; }
        g_grid = cus;
        fprintf(stderr, "kernel_launch: cus %d per_cu %d grid %d\n", cus, per_cu, g_grid);
    }
    Args base{};
    for (int i = 0; i < 30; ++i) base.in[i] = (const float*)d_in[i];
    base.out = (float*)d_out; base.ws = (unsigned char*)d_ws;
#if MK_ALL
    mk_launch(base, 0, NPHASE, stream);
    return;
#endif
#ifdef PROBE_PH
    mk_launch(base, 0, NPHASE, stream);
    { Args dry = base; dry.out = (float*)((unsigned char*)d_ws + WS_C);
      for (int i = 0; i < PROBE_N; ++i) mk_launch(dry, PROBE_PH, PROBE_PH + 1, stream); }
    return;
#endif
#ifdef WITH_NAIVE
    const float* x = base.in[I_X]; const float* c = base.in[I_C]; const float* ctx = base.in[I_CTX]; const float* c_ctx = base.in[I_CCTX];
    const float* w_mod = base.in[I_WMOD]; const float* b_mod = base.in[I_BMOD];
    const float* ln1_g = base.in[I_LN1G]; const float* ln1_b = base.in[I_LN1B]; const float* ln2_g = base.in[I_LN2G]; const float* ln2_b = base.in[I_LN2B];
    const float* ab_w_in = base.in[I_ABWIN]; const float* ab_b_in = base.in[I_ABBIN]; const float* ab_conv_w = base.in[I_CONVW]; const float* ab_conv_b = base.in[I_CONVB];
    const float* ab_conv_ln_g = base.in[I_CLNG]; const float* ab_conv_ln_b = base.in[I_CLNB]; const float* ab_q_norm_g = base.in[I_QNG]; const float* ab_k_norm_g = base.in[I_KNG];
    const float* ab_w_out = base.in[I_ABWOUT]; const float* ab_b_out = base.in[I_ABBOUT];
    const float* ml_w_in = base.in[I_MLWIN]; const float* ml_b_in = base.in[I_MLBIN]; const float* ml_norm_g = base.in[I_MLNG]; const float* ml_w_out = base.in[I_MLWOUT]; const float* ml_b_out = base.in[I_MLBOUT];
    const float* peer_w_q = base.in[I_PWQ]; const float* peer_k1 = base.in[I_PK1]; const float* peer_k2 = base.in[I_PK2]; const float* peer_u = base.in[I_PU]; const float* peer_v = base.in[I_PV];
    char* ws = (char*)d_ws;
    float* MOD = (float*)(ws + WS_MOD); float* GATE = (float*)(ws + WS_GATE); float* XC = (float*)(ws + WS_XC);
    bf16_t* HBF = (bf16_t*)(ws + WS_HBF); bf16_t* YBF = (bf16_t*)(ws + WS_YBF); int* EID = (int*)(ws + WS_EID); float* GW = (float*)(ws + WS_GW);
    bf16_t* GLU = (bf16_t*)(ws + WS_GLU); bf16_t* Qb = (bf16_t*)(ws + WS_Q); bf16_t* Kb = (bf16_t*)(ws + WS_K); bf16_t* Vb = (bf16_t*)(ws + WS_V);
    bf16_t* QM = (bf16_t*)(ws + WS_QM); bf16_t* KM = (bf16_t*)(ws + WS_KM); bf16_t* VM = (bf16_t*)(ws + WS_VM); bf16_t* OM = (bf16_t*)(ws + WS_OM);
    bf16_t* QP = (bf16_t*)(ws + WS_QP); bf16_t* NP = (bf16_t*)(ws + WS_NP);
    float* XL = (float*)d_out;
    const float* mod0 = MOD; const float* mod1 = MOD + 9 * NMOD;
#if MK_A
    mk_launch(base, 0, 1, stream); mk_launch(base, 1, 2, stream); mk_launch(base, 2, 3, stream);
#else
    mk_launch(base, 0, 1, stream);
    nk_mod<<<dim3(NMOD / 256, 9, 2), 256, 0, stream>>>(c, c_ctx, w_mod, b_mod, MOD);
    nk_ln_mod<<<TT, 256, 0, stream>>>(x, ctx, mod0, 0, D, HBF);
    nk_gemm<<<dim3(1024 / 64, TT / 64), 256, 0, stream>>>(HBF, ab_w_in, AB_IN, 0, 1024, ab_b_in, 1.f, NP);
    nk_glu<<<TT * 512 / 256, 256, 0, stream>>>(NP, GLU);
    nk_gemm<<<dim3(768 / 64, TT / 64), 256, 0, stream>>>(HBF, ab_w_in, AB_IN, 1024, 768, ab_b_in, 1.f, NP);
    nk_qkv<<<TT * 12 / 4, 256, 0, stream>>>(NP, ab_q_norm_g, ab_k_norm_g, Qb, Kb, Vb);
#endif
#if MK_B
    mk_launch(base, 3, 4, stream);
#else
    nk_attn<<<TT * 8 / 4, 256, 0, stream>>>(Qb, Kb, Vb, YBF);
    nk_conv<<<TT, 256, 0, stream>>>(GLU, ab_conv_w, ab_conv_b, ab_conv_ln_g, ab_conv_ln_b, YBF);
#endif
#if MK_C
    mk_launch(base, 4, 5, stream); mk_launch(base, 5, 6, stream); mk_launch(base, 6, 7, stream);
#else
    nk_gemm<<<dim3(1024 / 64, TT / 64), 256, 0, stream>>>(YBF, ab_w_out, D, 0, 1024, ab_b_out, 1.f, NP);
    nk_resid_ln<<<TT, 256, 0, stream>>>(x, ctx, XL, XC, NP, mod0, 2 * D, ln1_g, ln1_b);
    nk_ln_mod<<<TT, 256, 0, stream>>>(XL, XC, mod0, 3 * D, 4 * D, HBF);
    nk_gemm<<<dim3(2048 / 64, TT / 64), 256, 0, stream>>>(HBF, peer_w_q, 2048, 0, 2048, nullptr, 1.f, QP);
#endif
#if MK_D
    mk_launch(base, 7, 8, stream);
#else
    nk_peer_topk<<<TT, 256, 0, stream>>>(QP, peer_k1, peer_k2, EID, GW);
#endif
#if MK_E
    mk_launch(base, 8, 9, stream);
#else
    nk_peer_apply<<<TT, 256, 0, stream>>>(HBF, EID, GW, peer_u, peer_v, NP);
    nk_resid_ln<<<TT, 256, 0, stream>>>(XL, XC, XL, XC, NP, mod0, 5 * D, ln2_g, ln2_b);
    nk_ln_mod<<<TT, 256, 0, stream>>>(XL, XC, mod1, 0, D, HBF);
    nk_gates<<<TT / 4, 256, 0, stream>>>(HBF, ml_w_in, ml_b_in, GATE);
#endif
#if MK_F
    mk_launch(base, 9, 10, stream);
#else
    nk_gemm<<<dim3(512 / 64, TT / 64), 256, 0, stream>>>(HBF, ml_w_in, C_IN, 0, 512, ml_b_in, 1.f, QM);
    nk_gemm<<<dim3(512 / 64, TT / 64), 256, 0, stream>>>(HBF, ml_w_in, C_IN, 512, 512, ml_b_in, 0.08838834764831845f, KM);
    nk_gemm<<<dim3(1024 / 64, TT / 64), 256, 0, stream>>>(HBF, ml_w_in, C_IN, 1024, 1024, ml_b_in, 1.f, VM);
    nk_gemm<<<dim3(1024 / 64, TL / 64), 256, 0, stream>>>(HBF, ml_w_in, C_IN, 2048, 1024, ml_b_in, 1.f, OM);
#endif
#if MK_G
    mk_launch(base, 10, 11, stream); mk_launch(base, 11, 12, stream);
#else
    nk_mlstm<<<dim3(4, 4, NB * 2), 256, 0, stream>>>(QM, KM, VM, GATE, HBF, YBF);
    nk_ml_finish<<<TL, 256, 0, stream>>>(HBF, YBF, OM, ml_norm_g, YBF);
#endif
#if MK_H
    mk_launch(base, 12, 13, stream); mk_launch(base, 13, 14, stream); mk_launch(base, 14, 15, stream);
#else
    nk_gemm<<<dim3(1024 / 64, TL / 64), 256, 0, stream>>>(YBF, ml_w_out, D, 0, 1024, ml_b_out, 1.f, NP);
    nk_resid_ln<<<TL, 256, 0, stream>>>(XL, XC, XL, XC, NP, mod1, 2 * D, ln1_g + D, ln1_b + D);
    nk_ln_mod<<<TL, 256, 0, stream>>>(XL, XC, mod1, 3 * D, 4 * D, HBF);
    nk_gemm<<<dim3(2048 / 64, TL / 64), 256, 0, stream>>>(HBF, peer_w_q + (size_t)D * 2048, 2048, 0, 2048, nullptr, 1.f, QP);
#endif
#if MK_I
    mk_launch(base, 15, 16, stream);
#else
    nk_peer_topk<<<TL, 256, 0, stream>>>(QP, peer_k1 + 8 * 128 * 128, peer_k2 + 8 * 128 * 128, EID, GW);
#endif
#if MK_J
    mk_launch(base, 16, 17, stream);
#else
    nk_peer_apply<<<TL, 256, 0, stream>>>(HBF, EID, GW, peer_u + (size_t)16384 * D, peer_v + (size_t)16384 * D, NP);
    nk_resid_ln<<<TL, 256, 0, stream>>>(XL, XC, XL, XC, NP, mod1, 5 * D, ln2_g + D, ln2_b + D);
#endif
    (void)c; (void)c_ctx; (void)w_mod; (void)b_mod; (void)ab_w_in; (void)ab_b_in; (void)ab_q_norm_g; (void)ab_k_norm_g; (void)ab_w_out; (void)ab_b_out; (void)ml_w_in; (void)ml_b_in; (void)ml_w_out; (void)ml_b_out;
    (void)peer_w_q; (void)peer_u; (void)peer_v; (void)ln1_g; (void)ln1_b; (void)ln2_g; (void)ln2_b; (void)mod1; (void)NP; (void)GATE; (void)QM; (void)KM; (void)VM; (void)OM; (void)x; (void)ctx; (void)XC; (void)XL; (void)mod0;
    (void)GLU; (void)Qb; (void)Kb; (void)Vb; (void)EID; (void)GW; (void)QP; (void)HBF; (void)YBF; (void)ab_conv_w; (void)ab_conv_b; (void)ab_conv_ln_g; (void)ab_conv_ln_b; (void)ml_norm_g; (void)peer_k1; (void)peer_k2;
#endif
}
```

```cpp
#define MK_ALL 1
#define DEFER_TABLES 1
#define DEFER_Q1 10922
#define DEFER_Q2 21846
#include <hip/hip_runtime.h>
#include <cstdio>
#include <cstdint>
#include <cmath>

typedef unsigned short bf16_t;

constexpr int D = 1024, NB = 8, SEQ = 2048, CTX = 256;
constexpr int TL = NB * SEQ;
constexpr int TC = NB * CTX;
constexpr int TT = TL + TC;
constexpr int NMOD = 6 * D;
constexpr int KVLEN = CTX + SEQ;
constexpr int AB_IN = 1792, C_IN = 3088;
constexpr float EPS = 1e-6f;
constexpr float ALPHA = 1.4142135623730951f;
constexpr float QSCALE = 0.125f * 1.4426950408889634f;

constexpr size_t MiB = 1u << 20;
constexpr size_t WS_MOD  = 0;
constexpr size_t WS_GATE = 1 * MiB;
constexpr size_t WS_XC   = 3 * MiB;
constexpr size_t WS_HBF  = 11 * MiB;
constexpr size_t WS_YBF  = 47 * MiB;
constexpr size_t WS_EID  = 83 * MiB;
constexpr size_t WS_GW   = 92 * MiB;
constexpr size_t WS_C    = 101 * MiB;
constexpr size_t WS_GLU  = WS_C;
constexpr size_t WS_Q    = WS_C + 18 * MiB;
constexpr size_t WS_K    = WS_C + 36 * MiB;
constexpr size_t WS_V    = WS_C + 41 * MiB;
constexpr size_t WS_QM   = WS_C;
constexpr size_t WS_KM   = WS_C + 18 * MiB;
constexpr size_t WS_VM   = WS_C + 36 * MiB;
constexpr size_t WS_OM   = WS_C + 72 * MiB;
constexpr size_t WS_QP   = WS_C;
constexpr size_t WS_NP   = 209 * MiB;
constexpr size_t WS_END  = 245 * MiB;

__device__ __forceinline__ float bf2f(bf16_t v) { return __uint_as_float(((unsigned)v) << 16); }
__device__ __forceinline__ bf16_t f2bf(float f) { unsigned u = __float_as_uint(f); return (bf16_t)((u + 0x7fffu + ((u >> 16) & 1u)) >> 16); }
__device__ __forceinline__ float wave_sum(float v) {
#pragma unroll
    for (int o = 1; o < 64; o <<= 1) v += __shfl_xor(v, o);
    return v;
}
__device__ __forceinline__ float wave_max(float v) {
#pragma unroll
    for (int o = 1; o < 64; o <<= 1) v = fmaxf(v, __shfl_xor(v, o));
    return v;
}
__device__ __forceinline__ int mod_row(int r) { return r < TL ? r / SEQ : NB; }
__device__ __forceinline__ int kv_row(int r) { return r < TL ? (r / SEQ) * KVLEN + CTX + (r % SEQ) : ((r - TL) / CTX) * KVLEN + ((r - TL) % CTX); }
__device__ __forceinline__ float block_sum256(float v, float* red) {
    v = wave_sum(v);
    __syncthreads();
    if ((threadIdx.x & 63) == 0) red[threadIdx.x >> 6] = v;
    __syncthreads();
    return red[0] + red[1] + red[2] + red[3];
}

__device__ __forceinline__ int fresh_lane() { int l; asm volatile("v_mbcnt_lo_u32_b32 %0, -1, 0\n\tv_mbcnt_hi_u32_b32 %0, -1, %0" : "=v"(l)); return l; }
template <int M> __device__ __forceinline__ float xshfl(float v) {
    if constexpr (M < 32) return __int_as_float(__builtin_amdgcn_ds_swizzle(__float_as_int(v), 0x1F | (M << 10)));
    else { const auto rr = __builtin_amdgcn_permlane32_swap(__float_as_uint(v), __float_as_uint(v), false, false);
           return (__builtin_amdgcn_mbcnt_hi(~0u, __builtin_amdgcn_mbcnt_lo(~0u, 0u)) < 32u) ? __uint_as_float(rr[1]) : __uint_as_float(rr[0]); }
}
namespace pg8 {
#define PG8_LAS __attribute__((address_space(3)))
typedef unsigned short bf16_t;
typedef short bf16x8 __attribute__((ext_vector_type(8)));
typedef float f32x4 __attribute__((ext_vector_type(4)));
typedef unsigned u32x4 __attribute__((ext_vector_type(4)));
constexpr int BM = 256, BK = 64, HALF = 128, HTB = HALF * BK * 2  , STAGE_BYTES = 8 * HTB, NXCD = 8, WGM = 8;

__host__ __device__ __forceinline__ int lds_byte(int r, int c) { const int st = (r >> 4) * 2 + (c >> 5), rr = r & 15, cc = c & 31, ob = rr * 64 + cc * 2; return st * 1024 + (ob ^ (((ob >> 9) & 1) << 5)); }
__host__ __device__ __forceinline__ void stage_rc(int b, int& R, int& C) { const int st = b / 1024, sb = b % 1024, swz = sb ^ (((sb >> 9) & 1) << 5); R = (st >> 1) * 16 + swz / 64; C = (st & 1) * 32 + (swz % 64) / 2; }
__host__ __device__ __forceinline__ int perm32(int rho) { const int n = rho >> 4, i = rho & 15; return 8 * (i >> 2) + 4 * n + (i & 3); }

struct Unit { int pm, pn; };
struct Gemm { const bf16_t* A; const bf16_t* Bt; int M, N, K; };

struct StaticOrder {
    int nM, nN, nwg, G, c;
    __host__ __device__ void init(int M, int N, int G_, int c_) { nM = M / BM; nN = N / BM; nwg = nM * nN; G = G_; c = c_; }
    __host__ __device__ bool next(int i, Unit& u) const {
        const long L = (long)i * G + c; if (L >= nwg) return false;
        int wgid = (int)L; { const int q = nwg / NXCD, r = nwg % NXCD, xcd = wgid % NXCD, off = wgid / NXCD; wgid = (xcd < r ? xcd * (q + 1) : r * (q + 1) + (xcd - r) * q) + off; }
        const int nig = WGM * nN, gid = wgid / nig, fm = gid * WGM, gsz = (nM - fm) < WGM ? (nM - fm) : WGM;
        u.pm = fm + ((wgid % nig) % gsz); u.pn = (wgid % nig) / gsz; return true;
    }
    __device__ __forceinline__ void a_ready(const Unit&) const {}
    __device__ __forceinline__ void done(const Unit&) const {}
};
__device__ __forceinline__ unsigned cvt_pk_bf16(float lo, float hi) { unsigned r; asm volatile("v_cvt_pk_bf16_f32 %0, %1, %2" : "=v"(r) : "v"(lo), "v"(hi)); return r; }
template <class Epi, class Sched, bool ALIGN_EPI = false, bool SP2 = false>
__device__ __forceinline__ void gemm_phase(PG8_LAS unsigned char* lds, const Gemm g, const Sched& S, const Epi& E, const int wid) {
    const int lane = fresh_lane(), tid = wid * 64 + lane, wr = wid >> 2, wc = wid & 3, fr = lane & 15, fq = lane >> 4;
    const int K = g.K, nt = K / BK;
    unsigned voffA[2], voffB[2];
#pragma unroll
    for (int i = 0; i < 2; ++i) { int R, C; stage_rc(tid * 16 + i * 8192, R, C); const int Rb = Epi::PERM ? ((R & ~31) + perm32(R & 31)) : R;
        voffA[i] = (unsigned)(R * K + C) * 2u; voffB[i] = (unsigned)(Rb * K + C) * 2u; }
    const size_t kstep = (size_t)(BK * 2);
    const size_t hstep = (size_t)HALF * K * 2;
    const size_t tstep = 2 * hstep;
    const unsigned ldsw = (unsigned)wid * 1024u;
    const int aoff = lds_byte(wr * 64 + fr, fq * 8), boff = lds_byte(wc * 32 + fr, fq * 8);
#define PG8_SA(b, h) (((b) * 2 + (h)) * HTB)
#define PG8_SB(b, h) ((4 + (b) * 2 + (h)) * HTB)
#define PG8_STAGE(bufoff, gbase, voff) do { _Pragma("unroll") for (int _i = 0; _i < 2; ++_i) \
        __builtin_amdgcn_global_load_lds((const unsigned*)((const char*)(gbase) + (voff)[_i]), (PG8_LAS unsigned*)(lds + (bufoff) + ldsw + _i * 8192), 16, 0, 0); } while (0)
#define PG8_LDA(dst, b, h) do { _Pragma("unroll") for (int m = 0; m < 4; ++m) _Pragma("unroll") for (int k = 0; k < 2; ++k) dst[m][k] = *(const PG8_LAS bf16x8*)(lds + PG8_SA(b, h) + aoff + m * 2048 + k * 1024); } while (0)
#define PG8_LDB(dst, b, h) do { _Pragma("unroll") for (int n = 0; n < 2; ++n) _Pragma("unroll") for (int k = 0; k < 2; ++k) dst[n][k] = *(const PG8_LAS bf16x8*)(lds + PG8_SB(b, h) + boff + n * 2048 + k * 1024); } while (0)
#define PG8_MMA(ai, bj, At, Bt) do { __builtin_amdgcn_s_setprio(1); _Pragma("unroll") for (int m = 0; m < 4; ++m) _Pragma("unroll") for (int n = 0; n < 2; ++n) _Pragma("unroll") for (int k = 0; k < 2; ++k) \
        acc[ai][bj][m][n] = __builtin_amdgcn_mfma_f32_16x16x32_bf16(Bt[n][k], At[m][k], acc[ai][bj][m][n], 0, 0, 0); __builtin_amdgcn_s_setprio(0); } while (0)
#define PG8_WAIT_V(n) asm volatile("s_waitcnt vmcnt(" #n ")" ::: "memory")
#define PG8_WAIT_L(n) asm volatile("s_waitcnt lgkmcnt(" #n ")" ::: "memory")
#define PG8_BAR __builtin_amdgcn_s_barrier()
#define PG8_SCHED __builtin_amdgcn_sched_barrier(0)
    Unit cur, nxt; int ui = 0;
    if (!S.next(0, cur)) return;
    f32x4 acc[2][2][4][2];
#pragma unroll
    for (int a = 0; a < 2; ++a)
#pragma unroll
        for (int b = 0; b < 2; ++b)
#pragma unroll
            for (int m = 0; m < 4; ++m)
#pragma unroll
                for (int n = 0; n < 2; ++n) acc[a][b][m][n] = (f32x4){0.f, 0.f, 0.f, 0.f};
    bf16x8 At[4][2], B0[2][2], B1[2][2];
    const char* cA = (const char*)g.A + (size_t)cur.pm * tstep; const char* cB = (const char*)g.Bt + (size_t)cur.pn * tstep;
    S.a_ready(cur);
    if constexpr (SP2) {
        PG8_STAGE(PG8_SB(0, 0), cB, voffB); PG8_STAGE(PG8_SB(0, 1), cB + hstep, voffB); PG8_STAGE(PG8_SA(0, 0), cA, voffA); PG8_STAGE(PG8_SA(0, 1), cA + hstep, voffA);
        if (wr == 1) PG8_BAR;
        PG8_WAIT_V(2); PG8_BAR;
        PG8_STAGE(PG8_SB(1, 0), cB + kstep, voffB); PG8_STAGE(PG8_SA(1, 0), cA + kstep, voffA); PG8_STAGE(PG8_SB(1, 1), cB + hstep + kstep, voffB);
        PG8_WAIT_V(6); PG8_BAR;
    } else {
        PG8_STAGE(PG8_SB(0, 0), cB, voffB); PG8_STAGE(PG8_SA(0, 0), cA, voffA); PG8_STAGE(PG8_SB(0, 1), cB + hstep, voffB); PG8_STAGE(PG8_SA(0, 1), cA + hstep, voffA);
        if (wr == 1) PG8_BAR;
        PG8_WAIT_V(4); PG8_BAR;
        PG8_STAGE(PG8_SB(1, 0), cB + kstep, voffB); PG8_STAGE(PG8_SA(1, 0), cA + kstep, voffA); PG8_STAGE(PG8_SB(1, 1), cB + hstep + kstep, voffB);
        PG8_WAIT_V(6); PG8_BAR;
    }
    for (;;) {
        const bool has_next = S.next(ui + 1, nxt);
        const char* nA = has_next ? (const char*)g.A + (size_t)nxt.pm * tstep : cA; const char* nB = has_next ? (const char*)g.Bt + (size_t)nxt.pn * tstep : cB;
        for (int t = 0; t < nt; t += 2) {
            const bool last = (t == nt - 2);
            const char* a1 = cA + (size_t)(t + 1) * kstep;
            const char* a2 = last ? nA : cA + (size_t)(t + 2) * kstep; const char* b2 = last ? nB : cB + (size_t)(t + 2) * kstep;
            const char* a3 = a2 + kstep; const char* b3 = b2 + kstep;
            if (last && has_next) S.a_ready(nxt);
            if constexpr (SP2) {
            PG8_LDB(B0, 0, 0); PG8_LDB(B1, 0, 1); PG8_SCHED; PG8_LDA(At, 0, 0); PG8_STAGE(PG8_SA(1, 1), a1 + hstep, voffA);
            PG8_WAIT_V(8); PG8_WAIT_L(0); PG8_BAR; PG8_MMA(0, 0, At, B0); PG8_MMA(0, 1, At, B1); PG8_BAR; PG8_SCHED;
            PG8_LDA(At, 0, 1); PG8_STAGE(PG8_SB(0, 0), b2, voffB); PG8_STAGE(PG8_SB(0, 1), b2 + hstep, voffB); PG8_STAGE(PG8_SA(0, 0), a2, voffA);
            PG8_WAIT_V(8); PG8_WAIT_L(0); PG8_BAR; PG8_MMA(1, 0, At, B0); PG8_MMA(1, 1, At, B1); PG8_BAR; PG8_SCHED;
            PG8_LDB(B0, 1, 0); PG8_LDB(B1, 1, 1); PG8_SCHED; PG8_LDA(At, 1, 0); PG8_STAGE(PG8_SA(0, 1), a2 + hstep, voffA);
            PG8_WAIT_V(8); PG8_WAIT_L(0); PG8_BAR; PG8_MMA(0, 0, At, B0); PG8_MMA(0, 1, At, B1); PG8_BAR; PG8_SCHED;
            PG8_LDA(At, 1, 1); PG8_STAGE(PG8_SB(1, 0), b3, voffB); PG8_STAGE(PG8_SB(1, 1), b3 + hstep, voffB); PG8_STAGE(PG8_SA(1, 0), a3, voffA);
            PG8_WAIT_V(8); PG8_WAIT_L(0); PG8_BAR; PG8_MMA(1, 0, At, B0); PG8_MMA(1, 1, At, B1); PG8_BAR; PG8_SCHED;
            } else {
            PG8_LDB(B0, 0, 0); PG8_SCHED; PG8_LDA(At, 0, 0); PG8_STAGE(PG8_SA(1, 1), a1 + hstep, voffA);
            PG8_WAIT_L(8); PG8_BAR; PG8_WAIT_L(0); PG8_MMA(0, 0, At, B0); PG8_BAR; PG8_SCHED;
            PG8_LDB(B1, 0, 1); PG8_STAGE(PG8_SB(0, 0), b2, voffB);
            PG8_BAR; PG8_WAIT_L(0); PG8_MMA(0, 1, At, B1); PG8_BAR;
            PG8_LDA(At, 0, 1); PG8_STAGE(PG8_SA(0, 0), a2, voffA);
            PG8_BAR; PG8_WAIT_L(0); PG8_MMA(1, 0, At, B0); PG8_BAR; PG8_SCHED;
            PG8_STAGE(PG8_SB(0, 1), b2 + hstep, voffB);
            PG8_WAIT_V(6); PG8_BAR; PG8_MMA(1, 1, At, B1); PG8_BAR;
            PG8_LDB(B0, 1, 0); PG8_SCHED; PG8_LDA(At, 1, 0); PG8_STAGE(PG8_SA(0, 1), a2 + hstep, voffA);
            PG8_WAIT_L(8); PG8_BAR; PG8_WAIT_L(0); PG8_MMA(0, 0, At, B0); PG8_BAR; PG8_SCHED;
            PG8_LDB(B1, 1, 1); PG8_STAGE(PG8_SB(1, 0), b3, voffB);
            PG8_BAR; PG8_WAIT_L(0); PG8_MMA(0, 1, At, B1); PG8_BAR;
            PG8_LDA(At, 1, 1); PG8_STAGE(PG8_SA(1, 0), a3, voffA);
            PG8_BAR; PG8_WAIT_L(0); PG8_MMA(1, 0, At, B0); PG8_BAR; PG8_SCHED;
            PG8_STAGE(PG8_SB(1, 1), b3 + hstep, voffB);
            PG8_WAIT_V(6); PG8_BAR; PG8_MMA(1, 1, At, B1); PG8_BAR;
            }
        }
        if constexpr (ALIGN_EPI) { if (wr == 0) PG8_BAR; }
        if constexpr (!Epi::AFTER_DRAIN) { E(acc, cur, wr, wc, fr, fq); S.done(cur); }
        if (!has_next) break;
#pragma unroll
        for (int a = 0; a < 2; ++a)
#pragma unroll
            for (int b = 0; b < 2; ++b)
#pragma unroll
                for (int m = 0; m < 4; ++m)
#pragma unroll
                    for (int n = 0; n < 2; ++n) acc[a][b][m][n] = (f32x4){0.f, 0.f, 0.f, 0.f};
        cur = nxt; cA = nA; cB = nB; ++ui;
        if constexpr (ALIGN_EPI) { if (wr == 1) PG8_BAR; }
    }
    PG8_WAIT_V(0);
    if constexpr (!ALIGN_EPI) { if (wr == 0) PG8_BAR; }
    PG8_BAR;
    if constexpr (Epi::AFTER_DRAIN) { E.fused(acc, cur, wr, wc, fr, fq, lds, wid, lane); S.done(cur); }
#undef PG8_SA
#undef PG8_SB
#undef PG8_STAGE
#undef PG8_LDA
#undef PG8_LDB
#undef PG8_MMA
#undef PG8_WAIT_V
#undef PG8_WAIT_L
#undef PG8_BAR
#undef PG8_SCHED
}
}
#define LAS __attribute__((address_space(3)))
#define GAS __attribute__((address_space(1)))
typedef float f32x4 __attribute__((ext_vector_type(4)));
typedef unsigned u32x4 __attribute__((ext_vector_type(4)));
typedef unsigned u32x2 __attribute__((ext_vector_type(2)));
typedef __bf16 bf16x2_t __attribute__((ext_vector_type(2)));
typedef GAS unsigned gu32;

constexpr int NWAVES = 8, NTHR = 512;
constexpr int RING_BYTES = 139264, LDSCTL_OFF = RING_BYTES, MISC_OFF = LDSCTL_OFF + 320, LDS_BYTES = 147456;

constexpr size_t WS_CTL   = 245 * MiB;
constexpr size_t CTL_ZERO_BYTES = 32768;
constexpr size_t WS_WIN0  = 246 * MiB;
constexpr size_t WS_WOUT0 = 250 * MiB;
constexpr size_t WS_WIN1  = 252 * MiB;
constexpr size_t WS_WOUT1 = 258 * MiB;
constexpr size_t WS_WQ0   = 260 * MiB;
constexpr size_t WS_WQ1   = 264 * MiB;
constexpr size_t WS_K12   = 268 * MiB;
constexpr size_t WS_MISC  = 269 * MiB;
constexpr size_t WS_UT    = 270 * MiB;
constexpr size_t WS_VT    = 302 * MiB;
constexpr int ROWB = 768;
constexpr size_t WS_SC    = 334 * MiB;
constexpr size_t WS_XB    = 173 * MiB;
constexpr size_t WS_CB    = 355 * MiB;
constexpr size_t WS_KT    = 336 * MiB;
constexpr size_t WS_XS    = 366 * MiB;
constexpr size_t WS_END2  = 402 * MiB;
constexpr int CW_BAR = 4096;
constexpr size_t SM_BIASF = 0, SM_RC = 8192, SM_RS = 12288, SM_GWT = 16384, SM_LN1G = 81920, SM_LN1B = 90112, SM_LN2G = 98304, SM_LN2B = 106496, SM_CONVW = 114688, SM_CONVB = 178176,
                 SM_CLNG = 180224, SM_CLNB = 182272, SM_QNG = 184320, SM_KNG = 184576, SM_ABBOUT = 184832, SM_MLBIN = 188928, SM_MLNG = 201280, SM_MLBOUT = 205376, SM_W2 = 212992;
#define SMF(ws_, off_) ((const float*)((ws_) + WS_MISC + (off_)))

#define LDS_WAIT() asm volatile("s_waitcnt lgkmcnt(0)" ::: "memory")
#define VM_WAIT() asm volatile("s_waitcnt vmcnt(0)" ::: "memory")
typedef float f32x2_t_ __attribute__((ext_vector_type(2)));
__device__ __forceinline__ unsigned pk2(float lo, float hi) { f32x2_t_ v = {lo, hi}; bf16x2_t b = __builtin_convertvector(v, bf16x2_t); return __builtin_bit_cast(unsigned, b); }
__device__ __forceinline__ float bflo(unsigned u) { return __uint_as_float(u << 16); }
__device__ __forceinline__ float bfhi(unsigned u) { return __uint_as_float(u & 0xffff0000u); }
__device__ __forceinline__ float dot2bf(unsigned a, unsigned b, float c) { return __builtin_amdgcn_fdot2_f32_bf16(__builtin_bit_cast(bf16x2_t, a), __builtin_bit_cast(bf16x2_t, b), c, false); }
__device__ __forceinline__ float dot8bf(u32x4 a, u32x4 b, float c) { c = dot2bf(a.x, b.x, c); c = dot2bf(a.y, b.y, c); c = dot2bf(a.z, b.z, c); return dot2bf(a.w, b.w, c); }
__device__ __forceinline__ float sigmoidf_(float x) { return 1.f / (1.f + __expf(-x)); }
__device__ __forceinline__ float rl_f(float v, int l) { return __uint_as_float(__builtin_amdgcn_readlane(__float_as_uint(v), l)); }
__device__ __forceinline__ int rl_i(int v, int l) { return __builtin_amdgcn_readlane(v, l); }

#define XB_TMO      128
#define XB_XCNT(j)  (256  + 64 * (j))
#define XB_XSUB(j)  (1280 + 64 * (j))
#define XB_XGEN(j)  (2304 + 64 * (j))
#define XB_TOP      3328
#define XB_TOPGEN   3392
#define XCD_BAR_WORDS 3456
#define XB_SPIN_CAP (1u << 18)
__device__ __forceinline__ unsigned xb_ld(unsigned* p)              { return __hip_atomic_load(p, __ATOMIC_RELAXED, __HIP_MEMORY_SCOPE_AGENT); }
__device__ __forceinline__ unsigned xb_add(unsigned* p, unsigned v) { return __hip_atomic_fetch_add(p, v, __ATOMIC_RELAXED, __HIP_MEMORY_SCOPE_AGENT); }
__device__ __forceinline__ unsigned xb_xcc_id() { return (unsigned)__builtin_amdgcn_s_getreg((3 << 11) | 20) & 0xFu; }
#define XB_SPIN(cond, bar) do { unsigned _sp = 0; while (cond) { __builtin_amdgcn_s_sleep(1); \
    if ((++_sp & 255u) == 0u) { if (xb_ld(&(bar)[XB_TMO])) break; if (_sp > XB_SPIN_CAP) { atomicAdd(&(bar)[XB_TMO], 1u); break; } } } } while (0)
struct XcdBarrier { unsigned* bar; unsigned x; volatile LAS unsigned* st; };
__device__ __forceinline__ XcdBarrier xcd_barrier_post(unsigned* bar, volatile LAS unsigned* st, int wave) {
    XcdBarrier b; b.bar = bar; b.x = xb_xcc_id(); b.st = st;
    if (wave == 0 && fresh_lane() == 0) (void)xb_add(&bar[XB_XCNT(b.x)], 1u);
    return b;
}
__device__ __forceinline__ void xcd_barrier_complete(unsigned* bar, unsigned x, unsigned& nloc, unsigned& nx) {
    const unsigned G = gridDim.x * gridDim.y * gridDim.z;
    unsigned sum, cnt, mine, sp = 0u;
    for (;;) {
        sum = 0u; cnt = 0u; mine = 0u;
#pragma unroll
        for (unsigned j = 0; j < 16; ++j) { const unsigned c = xb_ld(&bar[XB_XCNT(j)]); sum += c; cnt += (c > 0u) ? 1u : 0u; mine = (j == x) ? c : mine; }
        if (sum == G) break;
        __builtin_amdgcn_s_sleep(1);
        if ((++sp & 255u) == 0u) { if (xb_ld(&bar[XB_TMO])) break; if (sp > XB_SPIN_CAP) { atomicAdd(&bar[XB_TMO], 1u); break; } }
    }
    nloc = mine > 0u ? mine : 1u; nx = cnt > 0u ? cnt : 1u;
}
__device__ __forceinline__ void xcd_barrier(const XcdBarrier& b, int wave) {
    asm volatile("s_waitcnt vmcnt(0)" ::: "memory");
    __syncthreads();
    if (wave == 0 && fresh_lane() == 0) {
        unsigned* bar = b.bar;
        __builtin_amdgcn_s_waitcnt(0);
        unsigned nloc = b.st[0], nx = b.st[1];
        if (nloc == 0u) { xcd_barrier_complete(bar, b.x, nloc, nx); b.st[0] = nloc; b.st[1] = nx; }
        const unsigned old = xb_add(&bar[XB_XSUB(b.x)], 1u);
        const unsigned gen = old / nloc;
        if (old + 1u == (gen + 1u) * nloc) {
            __builtin_amdgcn_fence(__ATOMIC_RELEASE, "agent");
            asm volatile("s_waitcnt vmcnt(0)" ::: "memory");
            const unsigned og = xb_add(&bar[XB_TOP], 1u);
            const unsigned tg = og / nx;
            if (og + 1u == (tg + 1u) * nx) xb_add(&bar[XB_TOPGEN], 1u);
            else XB_SPIN(xb_ld(&bar[XB_TOPGEN]) == tg, bar);
            __builtin_amdgcn_fence(__ATOMIC_ACQUIRE, "agent");
            xb_add(&bar[XB_XGEN(b.x)], 1u);
            asm volatile("s_waitcnt vmcnt(0)" ::: "memory");
        } else {
            XB_SPIN(xb_ld(&bar[XB_XGEN(b.x)]) == gen, bar);
            __builtin_amdgcn_fence(__ATOMIC_ACQUIRE, "agent");
            asm volatile("s_waitcnt vmcnt(0)" ::: "memory");
        }
    }
    __syncthreads();
}

struct Args { const float* in[30]; float* out; unsigned char* ws; int ph_lo, ph_hi; };
enum { I_X = 0, I_C, I_CTX, I_CCTX, I_WMOD, I_BMOD, I_LN1G, I_LN1B, I_LN2G, I_LN2B, I_ABWIN, I_ABBIN, I_CONVW, I_CONVB, I_CLNG, I_CLNB, I_QNG, I_KNG, I_ABWOUT, I_ABBOUT,
       I_MLWIN, I_MLBIN, I_MLNG, I_MLWOUT, I_MLBOUT, I_PWQ, I_PK1, I_PK2, I_PU, I_PV };

__host__ __device__ __forceinline__ int perm_in0(int n) {
    if (n < 512) return 256 * (n >> 7) + (n & 127);
    if (n < 1024) { const int c = n - 512; return 256 * (c >> 7) + 128 + (c & 127); }
    if (n < 1536) { const int c = n - 1024, hq = c >> 6, dd = c & 63; return 1024 + 256 * (hq >> 2) + 128 * (dd >> 5) + 32 * (hq & 3) + (dd & 31); }
    if (n < 1664) { const int c = n - 1536, hk = c >> 6, dd = c & 63; return 1536 + 128 * (dd >> 5) + 32 * hk + (dd & 31); }
    { const int c = n - 1664, hv = c >> 6, dd = c & 63; return 1536 + 128 * (dd >> 5) + 32 * (2 + hv) + (dd & 31); }
}
template <bool PERM0>
__device__ __forceinline__ void p0_transpose_item(const float* W, int ld, int nblk, bf16_t* WT, LAS float* scr, int item, int lane) {
    const int kb = item / nblk, nb = item % nblk, k0 = 64 * kb, n0 = 32 * nb;
    float tv[32];
#pragma unroll
    for (int i = 0; i < 32; ++i) { const int kk = 2 * i + (lane >> 5); tv[i] = __builtin_nontemporal_load(W + (size_t)(k0 + kk) * ld + n0 + (lane & 31)); }
#pragma unroll
    for (int i = 0; i < 32; ++i) { const int kk = 2 * i + (lane >> 5); scr[kk * 33 + (lane & 31)] = tv[i]; }
    LDS_WAIT(); asm volatile("" ::: "memory");
    const int c = lane & 7;
#pragma unroll
    for (int j = 0; j < 4; ++j) { const int n = (lane >> 3) + 8 * j; const LAS float* s = scr + (8 * c) * 33 + n;
        u32x4 o; o.x = pk2(s[0 * 33], s[1 * 33]); o.y = pk2(s[2 * 33], s[3 * 33]); o.z = pk2(s[4 * 33], s[5 * 33]); o.w = pk2(s[6 * 33], s[7 * 33]);
        const int row = PERM0 ? perm_in0(n0 + n) : (n0 + n);
        *(u32x4*)(WT + (size_t)row * 1024 + k0 + 8 * c) = o; }
    LDS_WAIT(); asm volatile("" ::: "memory");
}
__device__ __forceinline__ void p0_convert(const float* src, bf16_t* dst, size_t n8, int gw, int ngw, int lane) {
    for (size_t i = (size_t)gw * 64 + lane; i < n8; i += (size_t)ngw * 64) {
        const f32x4 a = ((const f32x4*)src)[2 * i], b = ((const f32x4*)src)[2 * i + 1];
        u32x4 o; o.x = pk2(a.x, a.y); o.y = pk2(a.z, a.w); o.z = pk2(b.x, b.y); o.w = pk2(b.z, b.w);
        ((u32x4*)dst)[i] = o;
    }
}
constexpr int P0W_IN0 = 16 * 56, P0W_SQ = 16 * 32, P0W_IN1 = 16 * 96, P0W_WQ = 16 * 64;
constexpr int P0W_NITEMS = P0W_IN0 + P0W_SQ + P0W_IN1 + P0W_SQ + 2 * P0W_WQ;
__device__ __forceinline__ void p0_weights(const Args& A, LAS float* scr, int ia, int ib, int widx, int nw, int lane) {
    unsigned char* ws = A.ws;
    for (int it = ia + widx; it < ib; it += nw) {
        int r = it;
        if (r < P0W_IN0) { p0_transpose_item<true>(A.in[I_ABWIN], AB_IN, 56, (bf16_t*)(ws + WS_WIN0), scr, r, lane); continue; } r -= P0W_IN0;
        if (r < P0W_SQ) { p0_transpose_item<false>(A.in[I_ABWOUT], D, 32, (bf16_t*)(ws + WS_WOUT0), scr, r, lane); continue; } r -= P0W_SQ;
        if (r < P0W_IN1) { p0_transpose_item<false>(A.in[I_MLWIN], C_IN, 96, (bf16_t*)(ws + WS_WIN1), scr, r, lane); continue; } r -= P0W_IN1;
        if (r < P0W_SQ) { p0_transpose_item<false>(A.in[I_MLWOUT], D, 32, (bf16_t*)(ws + WS_WOUT1), scr, r, lane); continue; } r -= P0W_SQ;
        if (r < P0W_WQ) { p0_transpose_item<false>(A.in[I_PWQ], 2048, 64, (bf16_t*)(ws + WS_WQ0), scr, r, lane); continue; } r -= P0W_WQ;
        p0_transpose_item<false>(A.in[I_PWQ] + (size_t)D * 2048, 2048, 64, (bf16_t*)(ws + WS_WQ1), scr, r, lane);
    }
}
__device__ __forceinline__ void p0_weight1(const float* W, int ld, int nb, bf16_t* dst, int nitems, LAS float* scr, int widx, int nw, int lane) {
    for (int it = widx; it < nitems; it += nw) p0_transpose_item<false>(W, ld, nb, dst, scr, it, lane);
}
__device__ __forceinline__ void p0_tables(const Args& A, int qa, int qb, int widx, int nw, int lane) {
    unsigned char* ws = A.ws;
    for (int q0 = qa + widx; q0 < qb; q0 += 2 * nw) {
        f32x4 v[2][2][4];
#pragma unroll
        for (int q = 0; q < 2; ++q) { const int qq = q0 + q * nw; if (qq < qb) { const int pr = (((qq >> 13) & 1) << 14) + ((qq >> 14) << 13) + (qq & 8191);
#pragma unroll
            for (int h = 0; h < 2; ++h) { const int rr = 2 * pr + h, tab = rr >> 14, row = rr & 16383;
                const float* src = (tab < 2 ? A.in[I_PU] : A.in[I_PV]) + ((size_t)(tab & 1) * 16384 + row) * D;
#pragma unroll
                for (int j = 0; j < 4; ++j) v[q][h][j] = __builtin_nontemporal_load((const f32x4*)src + lane + 64 * j); } } }
#pragma unroll
        for (int q = 0; q < 2; ++q) { const int qq = q0 + q * nw; if (qq < qb) { const int pr = (((qq >> 13) & 1) << 14) + ((qq >> 14) << 13) + (qq & 8191);
            typedef float f32x16_ __attribute__((ext_vector_type(16))); typedef unsigned u32x6_ __attribute__((ext_vector_type(6)));
            f32x16_ ab[2];
#pragma unroll
            for (int h = 0; h < 2; ++h) { const int rr = 2 * pr + h; float mx = 0.f;
#pragma unroll
                for (int j = 0; j < 4; ++j) mx = fmaxf(mx, fmaxf(fmaxf(fabsf(v[q][h][j].x), fabsf(v[q][h][j].y)), fmaxf(fabsf(v[q][h][j].z), fabsf(v[q][h][j].w))));
#pragma unroll
                for (int o = 1; o < 64; o <<= 1) mx = fmaxf(mx, __shfl_xor(mx, o));
                mx = fmaxf(mx, 1e-30f);
                const float inv = 7.5f / mx;
#pragma unroll
                for (int j = 0; j < 4; ++j) { ab[h][4 * j] = v[q][h][j].x * inv; ab[h][4 * j + 1] = v[q][h][j].y * inv; ab[h][4 * j + 2] = v[q][h][j].z * inv; ab[h][4 * j + 3] = v[q][h][j].w * inv; }
                if (lane == 0) ((float*)(ws + WS_SC))[rr] = mx * (1.f / 7.5f); }
            f32x16_ pe, po;
#pragma unroll
            for (int i = 0; i < 8; ++i) { pe[i] = ab[0][2 * i]; po[i] = ab[0][2 * i + 1]; pe[8 + i] = ab[1][2 * i]; po[8 + i] = ab[1][2 * i + 1]; }
            const u32x6_ p = __builtin_amdgcn_cvt_scalef32_2xpk16_fp6_f32(pe, po, 1.0f);
#pragma unroll
            for (int h = 0; h < 2; ++h) { const int rr = 2 * pr + h, tab = rr >> 14, row = rr & 16383;
                unsigned* dst = (unsigned*)(ws + (tab < 2 ? WS_UT : WS_VT) + ((size_t)(tab & 1) * 16384 + row) * ROWB) + lane * 3;
                __builtin_nontemporal_store(p[3 * h], dst); __builtin_nontemporal_store(p[3 * h + 1], dst + 1); __builtin_nontemporal_store(p[3 * h + 2], dst + 2); } } }
    }
}
__device__ __forceinline__ void p0_prologue(const Args& A, LAS unsigned char* lds, int vcu, int G, int tid) {
    const int lane = tid & 63, wave = __builtin_amdgcn_readfirstlane(tid >> 6);
    unsigned char* ws = A.ws;
    for (int it = vcu; it < 192; it += G) {
        const int l = it / 96, n0 = (it % 96) * 64;
        LAS float* sl = (LAS float*)lds; LAS float* red = sl + 9 * 1024;
        for (int i = tid; i < 9 * 1024; i += NTHR) { const int j = i >> 10, k = i & 1023; const float x = j < NB ? A.in[I_C][j * D + k] : A.in[I_CCTX][k]; sl[i] = x / (1.f + expf(-x)); }
        __syncthreads();
        f32x4 acc4[9];
#pragma unroll
        for (int j = 0; j < 9; ++j) acc4[j] = f32x4{0.f, 0.f, 0.f, 0.f};
        { const int rl = lane >> 4, cg = lane & 15;
          const float* w = A.in[I_WMOD] + ((size_t)l * D + wave * 128 + rl) * NMOD + n0 + 4 * cg;
          for (int b = 0; b < 2; ++b) {
              f32x4 wv[16];
#pragma unroll
              for (int i = 0; i < 16; ++i) wv[i] = __builtin_nontemporal_load((const f32x4*)(w + (size_t)(b * 64 + i * 4) * NMOD));
#pragma unroll
              for (int i = 0; i < 16; ++i) { const int k = wave * 128 + b * 64 + i * 4 + rl;
#pragma unroll
                  for (int j = 0; j < 9; ++j) acc4[j] = acc4[j] + wv[i] * sl[j * 1024 + k]; } }
#pragma unroll
          for (int j = 0; j < 9; ++j) {
              acc4[j].x += xshfl<16>(acc4[j].x); acc4[j].y += xshfl<16>(acc4[j].y); acc4[j].z += xshfl<16>(acc4[j].z); acc4[j].w += xshfl<16>(acc4[j].w);
              acc4[j].x += xshfl<32>(acc4[j].x); acc4[j].y += xshfl<32>(acc4[j].y); acc4[j].z += xshfl<32>(acc4[j].z); acc4[j].w += xshfl<32>(acc4[j].w); }
          if (rl == 0) {
#pragma unroll
              for (int j = 0; j < 9; ++j) *(LAS f32x4*)(red + (wave * 9 + j) * 64 + 4 * cg) = acc4[j]; } }
        __syncthreads();
        float* MOD = (float*)(ws + WS_MOD);
        for (int i = tid; i < 576; i += NTHR) { const int j = i >> 6, ln = i & 63; float s = A.in[I_BMOD][l * NMOD + n0 + ln];
#pragma unroll
            for (int w8 = 0; w8 < 8; ++w8) s += red[(w8 * 9 + j) * 64 + ln];
            MOD[((size_t)l * 9 + j) * NMOD + n0 + ln] = s; }
        __syncthreads();
    }
    { const int job = G - 1 - vcu;
        float* BIASF = (float*)(ws + WS_MISC); float* RC = (float*)(ws + WS_MISC + 8192); float* RS = (float*)(ws + WS_MISC + 12288); float* GWT = (float*)(ws + WS_MISC + 16384);
        if (job == 0) for (int n = tid; n < AB_IN; n += NTHR) BIASF[perm_in0(n)] = A.in[I_ABBIN][n];
        if (job == 0) for (int i = tid; i < 1024; i += NTHR) { const int pos = i >> 4, fi = i & 15; const float ang = (float)pos * powf(10000.f, -(float)fi / 16.f); RC[i] = cosf(ang); RS[i] = sinf(ang); }
        if (job == 1) for (int i = tid; i < 16 * 1024; i += NTHR) { const int j = i >> 10, k = i & 1023; GWT[i] = A.in[I_MLWIN][(size_t)k * C_IN + 3072 + j]; }
        if (job == 2) for (int i = tid; i < 16 * 512; i += NTHR) { const int jp = i >> 9, c = i & 511; const float w0 = A.in[I_CONVW][(2 * jp) * 512 + c], w1 = jp < 15 ? A.in[I_CONVW][(2 * jp + 1) * 512 + c] : 0.f;
            ((unsigned*)(ws + WS_MISC + SM_W2))[i] = pk2(w0, w1); }
        if (job == 3) { struct CP { int idx; size_t off; int n; };
          const CP cps[14] = {{I_LN1G, SM_LN1G, 2 * D}, {I_LN1B, SM_LN1B, 2 * D}, {I_LN2G, SM_LN2G, 2 * D}, {I_LN2B, SM_LN2B, 2 * D}, {I_CONVW, SM_CONVW, 31 * 512}, {I_CONVB, SM_CONVB, 512}, {I_CLNG, SM_CLNG, 512},
                              {I_CLNB, SM_CLNB, 512}, {I_QNG, SM_QNG, 64}, {I_KNG, SM_KNG, 64}, {I_ABBOUT, SM_ABBOUT, D}, {I_MLBIN, SM_MLBIN, C_IN}, {I_MLNG, SM_MLNG, D}, {I_MLBOUT, SM_MLBOUT, D}};
#pragma unroll
          for (int c = 0; c < 14; ++c) { const float* s = A.in[cps[c].idx]; float* d = (float*)(ws + WS_MISC + cps[c].off); for (int i = tid; i < cps[c].n; i += NTHR) d[i] = s[i]; } }
    }
    const int gw = vcu * NWAVES + wave, NGW = G * NWAVES;
    LAS float* scr = (LAS float*)(lds + wave * 16384);
#ifdef DEFER_TABLES
    p0_weights(A, scr, 0, P0W_IN0 + P0W_SQ, gw, NGW, lane);
#else
    p0_weights(A, scr, 0, P0W_NITEMS, gw, NGW, lane);
#endif
    { const int cw = G > 192 ? (vcu - 192) * NWAVES + wave : gw, cn = G > 192 ? (G - 192) * NWAVES : NGW;
      if (G <= 192 || vcu >= 192) for (size_t i = (size_t)cw * 64 + lane; i < (size_t)8 * 128 * 128 / 8; i += (size_t)cn * 64) {
          const float* s4[4] = {A.in[I_PK1], A.in[I_PK2], A.in[I_PK1] + 131072, A.in[I_PK2] + 131072};
          f32x4 a4[4], b4[4];
#pragma unroll
          for (int q = 0; q < 4; ++q) { a4[q] = ((const f32x4*)s4[q])[2 * i]; b4[q] = ((const f32x4*)s4[q])[2 * i + 1]; }
#pragma unroll
          for (int q = 0; q < 4; ++q) { u32x4 o; o.x = pk2(a4[q].x, a4[q].y); o.y = pk2(a4[q].z, a4[q].w); o.z = pk2(b4[q].x, b4[q].y); o.w = pk2(b4[q].z, b4[q].w);
              ((u32x4*)((bf16_t*)(ws + WS_K12) + (size_t)q * 131072))[i] = o; } } }
#ifndef DEFER_TABLES
    p0_tables(A, 0, 32768, gw, NGW, lane);
#endif
}

__device__ __forceinline__ float wsum(float v) {
    v += xshfl<1>(v); v += xshfl<2>(v); v += xshfl<4>(v); v += xshfl<8>(v); v += xshfl<16>(v); v += xshfl<32>(v);
    return v;
}
__device__ __forceinline__ void row_load(const float* row, int lane, f32x4 (&v)[4]) {
    const f32x4* p = (const f32x4*)row + lane;
#pragma unroll
    for (int j = 0; j < 4; ++j) v[j] = p[64 * j];
}
__device__ __forceinline__ void row_norm(f32x4 (&v)[4]) {
    float s = 0.f;
#pragma unroll
    for (int j = 0; j < 4; ++j) s += (v[j].x + v[j].y) + (v[j].z + v[j].w);
    const float mean = wsum(s) * (1.f / D); float s2 = 0.f;
#pragma unroll
    for (int j = 0; j < 4; ++j) { v[j] = v[j] - mean; s2 += (v[j].x * v[j].x + v[j].y * v[j].y) + (v[j].z * v[j].z + v[j].w * v[j].w); }
    const float rstd = rsqrtf(wsum(s2) * (1.f / D) + EPS);
#pragma unroll
    for (int j = 0; j < 4; ++j) v[j] = v[j] * rstd;
}
__device__ __forceinline__ void row_store_mod_bf16(bf16_t* orow, int lane, const f32x4 (&v)[4], const float* sh, const float* sc) {
    u32x2* o8 = (u32x2*)orow + lane;
#pragma unroll
    for (int j = 0; j < 4; ++j) { const f32x4 a = ((const f32x4*)sc)[lane + 64 * j], b = ((const f32x4*)sh)[lane + 64 * j]; const f32x4 y = v[j] * (a + 1.f) + b;
        u32x2 o; o.x = pk2(y.x, y.y); o.y = pk2(y.z, y.w); o8[64 * j] = o; }
}
__device__ __forceinline__ void p1_ln_mod(const Args& A, int gw, int NGW, int lane) {
    const float* MOD = (const float*)(A.ws + WS_MOD); bf16_t* HBF = (bf16_t*)(A.ws + WS_HBF);
#define P1_ROWPTR(q) ((q) < TL ? A.in[I_X] + (size_t)(q) * D : A.in[I_CTX] + (size_t)((q) - TL) * D)
    f32x4 n0[4], n1[4], m0[4], m1[4];
    if (gw < TT) { const int q1 = gw + NGW < TT ? gw + NGW : gw, q2 = gw + 2 * NGW < TT ? gw + 2 * NGW : gw, q3 = gw + 3 * NGW < TT ? gw + 3 * NGW : q2;
        row_load(P1_ROWPTR(gw), lane, n0); row_load(P1_ROWPTR(q1), lane, n1); row_load(P1_ROWPTR(q2), lane, m0); row_load(P1_ROWPTR(q3), lane, m1); }
    for (int r0 = gw; r0 < TT; r0 += 2 * NGW) {
        const int r1 = r0 + NGW; const bool two = r1 < TT;
        f32x4 v0[4], v1[4];
#pragma unroll
        for (int j = 0; j < 4; ++j) { v0[j] = n0[j]; v1[j] = n1[j]; n0[j] = m0[j]; n1[j] = m1[j]; }
        f32x4 sh0[4], sc0[4], sh1[4], sc1[4];
        { int lq = lane; asm volatile("" : "+v"(lq));
          const int q0 = r0 + 4 * NGW < TT ? r0 + 4 * NGW : r0, q1 = r0 + 5 * NGW < TT ? r0 + 5 * NGW : q0;
          row_load(P1_ROWPTR(q0), lq, m0); row_load(P1_ROWPTR(q1), lq, m1);
          const float* md0 = MOD + (size_t)mod_row(r0) * NMOD; const float* md1 = MOD + (size_t)mod_row(two ? r1 : r0) * NMOD;
#pragma unroll
          for (int j = 0; j < 4; ++j) { sh0[j] = ((const f32x4*)md0)[lq + 64 * j]; sc0[j] = ((const f32x4*)(md0 + D))[lq + 64 * j]; sh1[j] = ((const f32x4*)md1)[lq + 64 * j]; sc1[j] = ((const f32x4*)(md1 + D))[lq + 64 * j]; } }
        __builtin_amdgcn_sched_barrier(0);
        { row_norm(v0); u32x2* o8 = (u32x2*)(HBF + (size_t)r0 * D) + lane;
#pragma unroll
          for (int j = 0; j < 4; ++j) { const f32x4 y = v0[j] * (sc0[j] + 1.f) + sh0[j]; u32x2 o; o.x = pk2(y.x, y.y); o.y = pk2(y.z, y.w); o8[64 * j] = o; } }
        if (two) { row_norm(v1); u32x2* o8 = (u32x2*)(HBF + (size_t)r1 * D) + lane;
#pragma unroll
          for (int j = 0; j < 4; ++j) { const f32x4 y = v1[j] * (sc1[j] + 1.f) + sh1[j]; u32x2 o; o.x = pk2(y.x, y.y); o.y = pk2(y.z, y.w); o8[64 * j] = o; } }
    }
#undef P1_ROWPTR
}
__device__ __forceinline__ void row_load_bf16(const bf16_t* row, int lane, f32x4 (&v)[4]) {
    const u32x2* p = (const u32x2*)row + lane;
#pragma unroll
    for (int j = 0; j < 4; ++j) { const u32x2 w = p[64 * j]; v[j].x = bflo(w.x); v[j].y = bfhi(w.x); v[j].z = bflo(w.y); v[j].w = bfhi(w.y); }
}
__device__ __forceinline__ void p5_ln_ln_mod(const Args& A, int layer, int nrows, int gw, int NGW, int lane) {
    const float* MOD = (const float*)(A.ws + WS_MOD) + (size_t)layer * 9 * NMOD; bf16_t* HBF = (bf16_t*)(A.ws + WS_HBF); const bf16_t* XB = (const bf16_t*)(A.ws + WS_XB);
    const float* gam = SMF(A.ws, SM_LN1G) + layer * D; const float* bet = SMF(A.ws, SM_LN1B) + layer * D;
    u32x2 w0[4], w1[4];
    if (gw < nrows) { const u32x2* p0 = (const u32x2*)(XB + (size_t)gw * D) + lane; const u32x2* p1 = (const u32x2*)(XB + (size_t)(gw + NGW < nrows ? gw + NGW : gw) * D) + lane;
#pragma unroll
        for (int j = 0; j < 4; ++j) { w0[j] = p0[64 * j]; w1[j] = p1[64 * j]; } }
    for (int r0 = gw; r0 < nrows; r0 += 2 * NGW) {
        const int r1 = r0 + NGW; const bool two = r1 < nrows;
        bf16_t* XS = (bf16_t*)(A.ws + WS_XS);
        u32x2* x0 = (u32x2*)(XS + (size_t)r0 * D); u32x2* x1 = (u32x2*)(XS + (size_t)(two ? r1 : r0) * D);
        f32x4 v0[4], v1[4];
#pragma unroll
        for (int j = 0; j < 4; ++j) { v0[j].x = bflo(w0[j].x); v0[j].y = bfhi(w0[j].x); v0[j].z = bflo(w0[j].y); v0[j].w = bfhi(w0[j].y); v1[j].x = bflo(w1[j].x); v1[j].y = bfhi(w1[j].x); v1[j].z = bflo(w1[j].y); v1[j].w = bfhi(w1[j].y); }
        { const int n0 = r0 + 2 * NGW < nrows ? r0 + 2 * NGW : r0, n1 = r0 + 3 * NGW < nrows ? r0 + 3 * NGW : n0;
          int ln = lane; asm volatile("" : "+v"(ln));
          const u32x2* p0 = (const u32x2*)(XB + (size_t)n0 * D) + ln; const u32x2* p1 = (const u32x2*)(XB + (size_t)n1 * D) + ln;
#pragma unroll
          for (int j = 0; j < 4; ++j) { w0[j] = p0[64 * j]; w1[j] = p1[64 * j]; } }
        f32x4 g4[4], b4[4], sc0[4], sh0[4], sc1[4], sh1[4];
        { int lq = lane; asm volatile("" : "+v"(lq));
          const float* md0 = MOD + (size_t)mod_row(r0) * NMOD; const float* md1 = MOD + (size_t)mod_row(two ? r1 : r0) * NMOD;
#pragma unroll
          for (int j = 0; j < 4; ++j) { g4[j] = ((const f32x4*)gam)[lq + 64 * j]; b4[j] = ((const f32x4*)bet)[lq + 64 * j];
              sh0[j] = ((const f32x4*)(md0 + 3 * D))[lq + 64 * j]; sc0[j] = ((const f32x4*)(md0 + 4 * D))[lq + 64 * j]; sh1[j] = ((const f32x4*)(md1 + 3 * D))[lq + 64 * j]; sc1[j] = ((const f32x4*)(md1 + 4 * D))[lq + 64 * j]; } }
        __builtin_amdgcn_sched_barrier(0);
        { row_norm(v0);
#pragma unroll
          for (int j = 0; j < 4; ++j) { v0[j] = v0[j] * g4[j] + b4[j]; u32x2 w; w.x = pk2(v0[j].x, v0[j].y); w.y = pk2(v0[j].z, v0[j].w); x0[lane + 64 * j] = w; }
          row_norm(v0);
          u32x2* o8 = (u32x2*)(HBF + (size_t)r0 * D) + lane;
#pragma unroll
          for (int j = 0; j < 4; ++j) { const f32x4 y = v0[j] * (sc0[j] + 1.f) + sh0[j]; u32x2 o; o.x = pk2(y.x, y.y); o.y = pk2(y.z, y.w); o8[64 * j] = o; } }
        if (two) { row_norm(v1);
#pragma unroll
          for (int j = 0; j < 4; ++j) { v1[j] = v1[j] * g4[j] + b4[j]; u32x2 w; w.x = pk2(v1[j].x, v1[j].y); w.y = pk2(v1[j].z, v1[j].w); x1[lane + 64 * j] = w; }
          row_norm(v1);
          u32x2* o8 = (u32x2*)(HBF + (size_t)r1 * D) + lane;
#pragma unroll
          for (int j = 0; j < 4; ++j) { const f32x4 y = v1[j] * (sc1[j] + 1.f) + sh1[j]; u32x2 o; o.x = pk2(y.x, y.y); o.y = pk2(y.z, y.w); o8[64 * j] = o; } }
    }
}
namespace epi {
using pg8::Unit; using pg8::f32x4;
typedef unsigned u32x4 __attribute__((ext_vector_type(4)));
__device__ __forceinline__ u32x4 pack8(const f32x4& a, const f32x4& b) { u32x4 w; w.x = pk2(a.x, a.y); w.y = pk2(a.z, a.w); w.z = pk2(b.x, b.y); w.w = pk2(b.z, b.w); return w; }

struct EpiPlain {
    static constexpr bool PERM = true, AFTER_DRAIN = false;
    bf16_t* O; int ldc;
    __device__ __forceinline__ void operator()(const f32x4 (&acc)[2][2][4][2], const Unit& u, int wr, int wc, int fr, int fq) const {
        asm volatile("" : "+v"(fr), "+v"(fq));
        const int row0 = u.pm * 256 + wr * 64 + fr, col0 = u.pn * 256 + wc * 32 + 8 * fq;
#pragma unroll
        for (int ai = 0; ai < 2; ++ai)
#pragma unroll
            for (int m = 0; m < 4; ++m) { bf16_t* rowp = O + (size_t)(row0 + ai * 128 + m * 16) * ldc + col0;
#pragma unroll
                for (int bj = 0; bj < 2; ++bj) *(u32x4*)(rowp + bj * 128) = pack8(acc[ai][bj][m][0], acc[ai][bj][m][1]); }
    }
};

struct EpiIn1 {
    static constexpr bool PERM = true, AFTER_DRAIN = false;
    bf16_t *QM, *KM, *KT, *VT, *OM; const float* bias;
    __device__ __forceinline__ void operator()(const f32x4 (&acc)[2][2][4][2], const Unit& u, int wr, int wc, int fr, int fq) const {
        asm volatile("" : "+v"(fr), "+v"(fq));
        const int row0 = u.pm * 256 + wr * 64 + fr, pn = u.pn;
        const int bcol0 = pn * 256 + wc * 32 + 8 * fq;
        if (pn >= 8 && u.pm >= TL / 256) return;
        f32x4 bq[2][2];
        { int fq0 = fq; asm volatile("" : "+v"(fq0)); const float* bp0 = bias + pn * 256 + wc * 32 + 8 * fq0;
#pragma unroll
          for (int bj = 0; bj < 2; ++bj) { bq[bj][0] = *(const f32x4*)(bp0 + bj * 128); bq[bj][1] = *(const f32x4*)(bp0 + bj * 128 + 4); } }
#pragma unroll
        for (int ai = 0; ai < 2; ++ai)
#pragma unroll
            for (int m = 0; m < 4; ++m) { const int r = row0 + ai * 128 + m * 16;
                int fqi = fq; asm volatile("" : "+v"(fqi));
#pragma unroll
                for (int bj = 0; bj < 2; ++bj) {
                    f32x4 v0 = acc[ai][bj][m][0] + bq[bj][0], v1 = acc[ai][bj][m][1] + bq[bj][1];
                    const int col = (pn & 1) * 256 + bj * 128 + wc * 32 + 8 * fqi;
                    if (pn < 2) { *(u32x4*)(QM + (size_t)r * 512 + col) = pack8(v0, v1); }
                    else if (pn < 4) { v0 = v0 * 0.08838834764831845f; v1 = v1 * 0.08838834764831845f;
                        *(u32x4*)(KM + (size_t)r * 512 + col) = pack8(v0, v1);
                        bf16_t* kt = KT + ((size_t)(r >> 6) * 512 + col) * 64 + (r & 63);
                        kt[0] = f2bf(v0.x); kt[64] = f2bf(v0.y); kt[128] = f2bf(v0.z); kt[192] = f2bf(v0.w); kt[256] = f2bf(v1.x); kt[320] = f2bf(v1.y); kt[384] = f2bf(v1.z); kt[448] = f2bf(v1.w); }
                    else if (pn < 8) { const int vc = (pn - 4) * 256 + bj * 128 + wc * 32 + 8 * fqi;
                        bf16_t* vt = VT + ((size_t)(r >> 6) * 1024 + vc) * 64 + (r & 63);
                        vt[0] = f2bf(v0.x); vt[64] = f2bf(v0.y); vt[128] = f2bf(v0.z); vt[192] = f2bf(v0.w); vt[256] = f2bf(v1.x); vt[320] = f2bf(v1.y); vt[384] = f2bf(v1.z); vt[448] = f2bf(v1.w); }
                    else { const int oc = (pn - 8) * 256 + bj * 128 + wc * 32 + 8 * fqi; *(u32x4*)(OM + (size_t)r * 1024 + oc) = pack8(v0, v1); }
                }
            }
    }
};

struct EpiResid {
    static constexpr bool PERM = true, AFTER_DRAIN = false;
    const float *SL, *SC; const bf16_t* XSs; bf16_t* XB; const float* gate; const float* bias;
    __device__ __forceinline__ void operator()(const f32x4 (&acc)[2][2][4][2], const Unit& u, int wr, int wc, int fr, int fq) const {
        asm volatile("" : "+v"(fr), "+v"(fq));
        const int row0 = u.pm * 256 + wr * 64 + fr, col0 = u.pn * 256 + wc * 32 + 8 * fq;
        f32x4 bv[2][2];
#pragma unroll
        for (int bj = 0; bj < 2; ++bj)
#pragma unroll
            for (int n = 0; n < 2; ++n) bv[bj][n] = *(const f32x4*)(bias + col0 + bj * 128 + 4 * n);
#pragma unroll
        for (int ai = 0; ai < 2; ++ai)
#pragma unroll
            for (int m = 0; m < 4; ++m) { const int r = row0 + ai * 128 + m * 16;
                const float* xs = r < TL ? SL + (size_t)r * D : SC + (size_t)(r - TL) * D;
                const float* g = gate + (size_t)mod_row(r) * NMOD;
#pragma unroll
                for (int bj = 0; bj < 2; ++bj) { const int c = col0 + bj * 128;
                    f32x4 x0, x1;
                    if (XSs) { const u32x4 xw = *(const u32x4*)(XSs + (size_t)r * D + c); x0.x = bflo(xw.x); x0.y = bfhi(xw.x); x0.z = bflo(xw.y); x0.w = bfhi(xw.y); x1.x = bflo(xw.z); x1.y = bfhi(xw.z); x1.z = bflo(xw.w); x1.w = bfhi(xw.w); }
                    else { x0 = __builtin_nontemporal_load((const f32x4*)(xs + c)); x1 = __builtin_nontemporal_load((const f32x4*)(xs + c + 4)); }
                    const f32x4 g0 = *(const f32x4*)(g + c), g1 = *(const f32x4*)(g + c + 4);
                    *(u32x4*)(XB + (size_t)r * D + c) = pack8(x0 * ALPHA + g0 * (acc[ai][bj][m][0] + bv[bj][0]), x1 * ALPHA + g1 * (acc[ai][bj][m][1] + bv[bj][1])); } }
    }
};

struct EpiIn0 {
    static constexpr bool PERM = true, AFTER_DRAIN = false;
    bf16_t *GLU, *Q, *K, *V; const float *biasf, *qg, *kg, *rc, *rs;
    __device__ __forceinline__ void operator()(const f32x4 (&acc)[2][2][4][2], const Unit& u, int wr, int wc, int fr, int fq) const {
        asm volatile("" : "+v"(fr), "+v"(fq));
        const int row0 = u.pm * 256 + wr * 64 + fr, pn = u.pn;
        if (pn < 4) {
            f32x4 bvA[2], bvB[2];
            { int fq0 = fq; asm volatile("" : "+v"(fq0)); const float* bp0 = biasf + pn * 256 + wc * 32 + 8 * fq0;
#pragma unroll
              for (int n = 0; n < 2; ++n) { bvA[n] = *(const f32x4*)(bp0 + 4 * n); bvB[n] = *(const f32x4*)(bp0 + 128 + 4 * n); } }
#pragma unroll
            for (int ai = 0; ai < 2; ++ai)
#pragma unroll
                for (int m = 0; m < 4; ++m) { const int r = row0 + ai * 128 + m * 16;
                    int fqi = fq; asm volatile("" : "+v"(fqi));
                    f32x4 o[2];
#pragma unroll
                    for (int n = 0; n < 2; ++n) { const f32x4 a = acc[ai][0][m][n] + bvA[n], g = acc[ai][1][m][n] + bvB[n];
                        o[n].x = a.x * sigmoidf_(g.x); o[n].y = a.y * sigmoidf_(g.y); o[n].z = a.z * sigmoidf_(g.z); o[n].w = a.w * sigmoidf_(g.w); }
                    *(u32x4*)(GLU + (size_t)r * 512 + pn * 128 + wc * 32 + 8 * fqi) = pack8(o[0], o[1]); }
            return;
        }
        const bool isv = (pn == 6 && wc >= 2);
        const bool isq = (pn < 6);
        const float* gn = isq ? qg : kg;
        const bool lat = u.pm < TL / 256;
        f32x4 bA[2], bB[2], gA[2], gB[2];
        { int fq0 = fq; asm volatile("" : "+v"(fq0));
          const float* bp0 = biasf + pn * 256 + wc * 32 + 8 * fq0;
#pragma unroll
          for (int n = 0; n < 2; ++n) { bA[n] = *(const f32x4*)(bp0 + 4 * n); bB[n] = *(const f32x4*)(bp0 + 128 + 4 * n); gA[n] = *(const f32x4*)(gn + 8 * fq0 + 4 * n); gB[n] = *(const f32x4*)(gn + 32 + 8 * fq0 + 4 * n); } }
#pragma unroll
        for (int ai = 0; ai < 2; ++ai) {
            f32x4 caH[2], saH[2];
            { int fq1 = fq; asm volatile("" : "+v"(fq1));
              const int prowH = ((row0 + ai * 128) & (SEQ - 1)) >> 6, fiH = 8 * (fq1 & 1);
#pragma unroll
              for (int n = 0; n < 2; ++n) { caH[n] = *(const f32x4*)(rc + prowH * 16 + fiH + 4 * n); saH[n] = *(const f32x4*)(rs + prowH * 16 + fiH + 4 * n); } }
#pragma unroll
            for (int m = 0; m < 4; ++m) { const int r = row0 + ai * 128 + m * 16;
                int fqi = fq; asm volatile("" : "+v"(fqi));
                f32x4 xa[2], xb[2];
#pragma unroll
                for (int n = 0; n < 2; ++n) { xa[n] = acc[ai][0][m][n] + bA[n]; xb[n] = acc[ai][1][m][n] + bB[n]; }
                if (!isv) {
                    float ss = 0.f;
#pragma unroll
                    for (int n = 0; n < 2; ++n) ss += (xa[n].x * xa[n].x + xa[n].y * xa[n].y) + (xa[n].z * xa[n].z + xa[n].w * xa[n].w) + (xb[n].x * xb[n].x + xb[n].y * xb[n].y) + (xb[n].z * xb[n].z + xb[n].w * xb[n].w);
                    ss += xshfl<16>(ss); ss += xshfl<32>(ss);
                    const float rstd = rsqrtf(ss * (1.f / 64.f) + EPS);
#pragma unroll
                    for (int n = 0; n < 2; ++n) { xa[n] = xa[n] * rstd * gA[n]; xb[n] = xb[n] * rstd * gB[n]; }
                    if (lat) {
                        const int t = r & (SEQ - 1), prow = t >> 6, pcol = t & 63, fi0 = 8 * (fqi & 1);
                        const bool lower = fqi < 2;
#pragma unroll
                        for (int n = 0; n < 2; ++n) {
                            const f32x4 ca = caH[n], sa = saH[n];
                            const f32x4 cb = *(const f32x4*)(rc + pcol * 16 + fi0 + 4 * n), sb = *(const f32x4*)(rs + pcol * 16 + fi0 + 4 * n);
                            f32x4 oa, ob;
                            oa.x = xshfl<32>(xa[n].x); oa.y = xshfl<32>(xa[n].y); oa.z = xshfl<32>(xa[n].z); oa.w = xshfl<32>(xa[n].w);
                            ob.x = xshfl<32>(xb[n].x); ob.y = xshfl<32>(xb[n].y); ob.z = xshfl<32>(xb[n].z); ob.w = xshfl<32>(xb[n].w);
                            xa[n] = lower ? (xa[n] * ca - oa * sa) : (xa[n] * ca + oa * sa);
                            xb[n] = lower ? (xb[n] * cb - ob * sb) : (xb[n] * cb + ob * sb);
                        }
                    }
                }
                if (isq) {
                    const int head = 4 * (pn - 4) + wc;
                    bf16_t* qp = Q + (size_t)r * 512 + head * 64 + 8 * fqi;
                    *(u32x4*)qp = pack8(xa[0] * QSCALE, xa[1] * QSCALE); *(u32x4*)(qp + 32) = pack8(xb[0] * QSCALE, xb[1] * QSCALE);
                } else {
                    bf16_t* kp = (isv ? V : K) + (size_t)kv_row(r) * 128 + (wc & 1) * 64 + 8 * fqi;
                    *(u32x4*)kp = pack8(xa[0], xa[1]); *(u32x4*)(kp + 32) = pack8(xb[0], xb[1]);
                }
            }
        }
    }
};
}

__host__ __device__ constexpr int bitrev3(int k) { return ((k & 1) << 2) | (k & 2) | ((k >> 2) & 1); }
__host__ __device__ constexpr int bitrev5(int k) { return ((k & 1) << 4) | ((k & 2) << 2) | (k & 4) | ((k & 8) >> 2) | ((k >> 4) & 1); }
__host__ __device__ constexpr int bitrev4(int k) { return ((k & 1) << 3) | ((k & 2) << 1) | ((k & 4) >> 1) | ((k >> 3) & 1); }
template <int N, int MSK, int M> __device__ __forceinline__ void treduce_stepm(float (&d)[M], int lane) {
    const int m = MSK; const bool up = (lane & m) != 0;
#pragma unroll
    for (int i = 0; i < N / 2; ++i) { const float send = up ? d[i] : d[i + N / 2]; const float keep = up ? d[i + N / 2] : d[i]; d[i] = keep + xshfl<MSK>(send); }
}
__device__ __forceinline__ float gelu_erf(float s) { return 0.5f * s * (1.f + erff(s * 0.70710678118654752f)); }

typedef float f32x32v __attribute__((ext_vector_type(32)));
typedef _Float16 h2v __attribute__((ext_vector_type(2)));
typedef _Float16 h32v __attribute__((ext_vector_type(32)));
__device__ __forceinline__ h2v mkh2(float a, float b) { return h2v{(_Float16)a, (_Float16)b}; }
#define HP(R, j) (h2v{(R)[2 * (j)], (R)[2 * (j) + 1]})
typedef unsigned u32x6v __attribute__((ext_vector_type(6)));
typedef unsigned u32x3v __attribute__((ext_vector_type(3)));
__device__ __forceinline__ __amdgpu_buffer_rsrc_t peer_rsrc(const unsigned char* p) {
    const unsigned long long a = (unsigned long long)p;
    const unsigned lo = __builtin_amdgcn_readfirstlane((unsigned)a), hi = __builtin_amdgcn_readfirstlane((unsigned)(a >> 32));
    return __builtin_amdgcn_make_buffer_rsrc((void*)(((unsigned long long)hi << 32) | lo), (short)0, 16384 * ROWB, 0x00020000);
}
template <int ABLP>
__device__ __forceinline__ void peer_apply_phase_t(const Args& A, LAS unsigned char* lds, int wave, int layer, int nrows, bool last, int gw, int NGW, int lane) {
    const bf16_t* HBFr = (const bf16_t*)(A.ws + WS_HBF); bf16_t* HBFw = (bf16_t*)(A.ws + WS_HBF);
    const int* EID = (const int*)(A.ws + WS_EID); const float* GWp = (const float*)(A.ws + WS_GW);
    const unsigned char* UT = A.ws + WS_UT + (size_t)layer * 16384 * ROWB; const unsigned char* VT = A.ws + WS_VT + (size_t)layer * 16384 * ROWB;
    const float* US = (const float*)(A.ws + WS_SC) + (size_t)layer * 16384; const float* VS = (const float*)(A.ws + WS_SC) + (size_t)(2 + layer) * 16384;
    const float* MOD = (const float*)(A.ws + WS_MOD) + (size_t)layer * 9 * NMOD;
    const float* MODN = (const float*)(A.ws + WS_MOD) + (size_t)(layer + 1) * 9 * NMOD;
    const float* gam = SMF(A.ws, SM_LN2G) + layer * D; const float* bet = SMF(A.ws, SM_LN2B) + layer * D;
    const float* GWT = (const float*)(A.ws + WS_MISC + 16384); float* GATE = (float*)(A.ws + WS_GATE);
    const __amdgpu_buffer_rsrc_t rsU = peer_rsrc(UT), rsV = peer_rsrc(VT); const int voff = lane * 12;
    const __amdgpu_buffer_rsrc_t rsG = __builtin_amdgcn_make_buffer_rsrc((void*)GWT, (short)0, 16 * D * 4, 0x00020000);
    float* CB = (float*)(A.ws + WS_CB);
    if (!last) {
        __syncthreads();
        for (int i = wave * 64 + lane; i < 16 * D / 4; i += NTHR) ((LAS f32x4*)lds)[i] = ((const f32x4*)GWT)[i];
        __syncthreads();
    }
    int pn0 = 0, pn1 = 0;
    if (gw < nrows) { int lp = lane; asm volatile("" : "+v"(lp)); pn0 = EID[(size_t)gw * 128 + lp]; pn1 = EID[(size_t)gw * 128 + 64 + lp]; }
    for (int r = gw; r < nrows; r += NGW) {
        int ln = lane; asm volatile("" : "+v"(ln));
        const bf16_t* hrow = HBFr + (size_t)r * D + ln * 4;
        float hf[16];
#pragma unroll
        for (int j = 0; j < 4; ++j) { const u32x2 h2 = __builtin_nontemporal_load((const u32x2*)(hrow + 256 * j));        hf[4 * j] = bflo(h2.x); hf[4 * j + 1] = bfhi(h2.x); hf[4 * j + 2] = bflo(h2.y); hf[4 * j + 3] = bfhi(h2.y); }
        h2v hh[8];
#pragma unroll
        for (int i = 0; i < 8; ++i) hh[i] = mkh2(hf[2 * i], hf[2 * i + 1]);
        const int e0 = pn0, e1 = pn1;
        { const int rnx = r + NGW < nrows ? r + NGW : r; pn0 = EID[(size_t)rnx * 128 + ln]; pn1 = EID[(size_t)rnx * 128 + 64 + ln]; }
        float c0 = 0.f, c1 = 0.f;
        for (int bt = 0; bt < 4; ++bt) {
            const int ev = bt < 2 ? e0 : e1;
            u32x3v ur[32];
#pragma unroll
            for (int k = 0; k < 32; ++k) { const int id = ABLP == 1 ? k : rl_i(ev, (bt & 1) * 32 + bitrev5(k)); ur[k] = __builtin_bit_cast(u32x3v, __builtin_amdgcn_raw_buffer_load_b96(rsU, voff, id * ROWB, 0)); }
            float d[32];
            if (ABLP == 2) { _Pragma("unroll") for (int k = 0; k < 32; ++k) d[k] = __uint_as_float(ur[k].x ^ ur[k].y ^ ur[k].z); } else
#pragma unroll
            for (int k = 0; k < 32; k += 2) { u32x6v w; w[0] = ur[k].x; w[1] = ur[k].y; w[2] = ur[k].z; w[3] = ur[k + 1].x; w[4] = ur[k + 1].y; w[5] = ur[k + 1].z;
                const h32v R = __builtin_amdgcn_cvt_scalef32_pk32_f16_fp6(w, 1.0f);
                float a0 = 0.f, a1 = 0.f, b0 = 0.f, b1 = 0.f;
#pragma unroll
                for (int i = 0; i < 8; i += 2) { a0 = __builtin_amdgcn_fdot2(HP(R, i), hh[i], a0, false); a1 = __builtin_amdgcn_fdot2(HP(R, i + 1), hh[i + 1], a1, false);
                    b0 = __builtin_amdgcn_fdot2(HP(R, 8 + i), hh[i], b0, false); b1 = __builtin_amdgcn_fdot2(HP(R, 9 + i), hh[i + 1], b1, false); }
                d[k] = a0 + a1; d[k + 1] = b0 + b1; __builtin_amdgcn_sched_barrier(0); }
            treduce_stepm<32, 1>(d, lane); treduce_stepm<16, 2>(d, lane); treduce_stepm<8, 4>(d, lane); treduce_stepm<4, 8>(d, lane); treduce_stepm<2, 16>(d, lane);
            float s = d[0]; s += xshfl<32>(s);
            if ((lane >> 5) == (bt & 1)) { if (bt < 2) c0 = s; else c1 = s; }
        }
        { int lm = lane, ea = e0, eb = e1; asm volatile("" : "+v"(lm), "+v"(ea), "+v"(eb));
          const float g0 = GWp[(size_t)r * 128 + lm], g1 = GWp[(size_t)r * 128 + 64 + lm];
          const float su0 = US[ea], su1 = US[eb], sv0 = VS[ea], sv1 = VS[eb];
          c0 = g0 * gelu_erf(c0 * su0) * sv0; c1 = g1 * gelu_erf(c1 * su1) * sv1;
          CB[(size_t)r * 128 + lm] = c0; CB[(size_t)r * 128 + 64 + lm] = c1; }
    }
    int qn0 = 0, qn1 = 0; float qc0 = 0.f, qc1 = 0.f;
    if (gw < nrows) { int lp = lane; asm volatile("" : "+v"(lp)); qn0 = EID[(size_t)gw * 128 + lp]; qn1 = EID[(size_t)gw * 128 + 64 + lp]; qc0 = CB[(size_t)gw * 128 + lp]; qc1 = CB[(size_t)gw * 128 + 64 + lp]; }
    for (int r = gw; r < nrows; r += NGW) {
        int ln = lane; asm volatile("" : "+v"(ln));
        const int e0 = qn0, e1 = qn1; const float c0 = qc0, c1 = qc1;
        { const int rnx = r + NGW < nrows ? r + NGW : r; qn0 = EID[(size_t)rnx * 128 + ln]; qn1 = EID[(size_t)rnx * 128 + 64 + ln]; qc0 = CB[(size_t)rnx * 128 + ln]; qc1 = CB[(size_t)rnx * 128 + 64 + ln]; }
        const unsigned c0h = __builtin_bit_cast(unsigned, mkh2(c0, c0)), c1h = __builtin_bit_cast(unsigned, mkh2(c1, c1));
        float acc[16];
#pragma unroll
        for (int i = 0; i < 16; ++i) acc[i] = 0.f;
        for (int bt = 0; bt < 8; ++bt) {
            const int ev = bt < 4 ? e0 : e1; const unsigned cvh = bt < 4 ? c0h : c1h;
            u32x3v vr[16]; h2v ah[8];
#pragma unroll
            for (int i = 0; i < 8; ++i) ah[i] = mkh2(0.f, 0.f);
#pragma unroll
            for (int k = 0; k < 16; ++k) { const int id = ABLP == 1 ? k : rl_i(ev, (bt & 3) * 16 + k); vr[k] = __builtin_bit_cast(u32x3v, __builtin_amdgcn_raw_buffer_load_b96(rsV, voff, id * ROWB, 0)); }
            if (ABLP == 2) { _Pragma("unroll") for (int k = 0; k < 16; ++k) acc[k] += __uint_as_float(vr[k].x ^ vr[k].y ^ vr[k].z); } else
#pragma unroll
            for (int k = 0; k < 16; k += 2) { const h2v ca = __builtin_bit_cast(h2v, (unsigned)rl_i((int)cvh, (bt & 3) * 16 + k)), cb = __builtin_bit_cast(h2v, (unsigned)rl_i((int)cvh, (bt & 3) * 16 + k + 1));
                u32x6v w; w[0] = vr[k].x; w[1] = vr[k].y; w[2] = vr[k].z; w[3] = vr[k + 1].x; w[4] = vr[k + 1].y; w[5] = vr[k + 1].z;
                const h32v R = __builtin_amdgcn_cvt_scalef32_pk32_f16_fp6(w, 1.0f);
#pragma unroll
                for (int i = 0; i < 8; ++i) { ah[i] = __builtin_elementwise_fma(HP(R, i), ca, ah[i]); ah[i] = __builtin_elementwise_fma(HP(R, 8 + i), cb, ah[i]); }
                __builtin_amdgcn_sched_barrier(0); }
#pragma unroll
            for (int i = 0; i < 8; ++i) { acc[2 * i] += (float)ah[i].x; acc[2 * i + 1] += (float)ah[i].y; }
        }
        int le = lane; asm volatile("" : "+v"(le));
        bf16_t* xsrow = (bf16_t*)(A.ws + WS_XS) + (size_t)r * D + le * 4; float* xrow = A.out + (size_t)(r < TL ? r : 0) * D + le * 4;
        const float* md = MOD + (size_t)mod_row(r) * NMOD + 5 * D + le * 4;
        float v[16]; float s = 0.f;
#pragma unroll
        for (int q = 0; q < 4; ++q) { const u32x2 xw = __builtin_nontemporal_load((const u32x2*)(xsrow + 256 * q)); f32x4 xv; xv.x = bflo(xw.x); xv.y = bfhi(xw.x); xv.z = bflo(xw.y); xv.w = bfhi(xw.y); const f32x4 gv = *(const f32x4*)(md + 256 * q);
            v[4 * q + 0] = ALPHA * xv.x + gv.x * acc[4 * q + 0]; v[4 * q + 1] = ALPHA * xv.y + gv.y * acc[4 * q + 1]; v[4 * q + 2] = ALPHA * xv.z + gv.z * acc[4 * q + 2]; v[4 * q + 3] = ALPHA * xv.w + gv.w * acc[4 * q + 3];
            s += (v[4 * q] + v[4 * q + 1]) + (v[4 * q + 2] + v[4 * q + 3]); }
        float mean = wsum(s) * (1.f / D), s2 = 0.f;
#pragma unroll
        for (int i = 0; i < 16; ++i) { v[i] -= mean; s2 += v[i] * v[i]; }
        float rstd = rsqrtf(wsum(s2) * (1.f / D) + EPS);
        s = 0.f;
#pragma unroll
        for (int q = 0; q < 4; ++q) { const f32x4 gv = *(const f32x4*)(gam + le * 4 + 256 * q), bv = *(const f32x4*)(bet + le * 4 + 256 * q);
            f32x4 y; y.x = v[4 * q] * rstd * gv.x + bv.x; y.y = v[4 * q + 1] * rstd * gv.y + bv.y; y.z = v[4 * q + 2] * rstd * gv.z + bv.z; y.w = v[4 * q + 3] * rstd * gv.w + bv.w;
            if (last) __builtin_nontemporal_store(y, (f32x4*)(xrow + 256 * q)); else {        u32x2 w; w.x = pk2(y.x, y.y); w.y = pk2(y.z, y.w); *(u32x2*)(xsrow + 256 * q) = w; }
            v[4 * q] = y.x; v[4 * q + 1] = y.y; v[4 * q + 2] = y.z; v[4 * q + 3] = y.w; s += (y.x + y.y) + (y.z + y.w); }
        if (last) continue;
        mean = wsum(s) * (1.f / D); s2 = 0.f;
#pragma unroll
        for (int i = 0; i < 16; ++i) { v[i] -= mean; s2 += v[i] * v[i]; }
        rstd = rsqrtf(wsum(s2) * (1.f / D) + EPS);
        const float* mdn = MODN + (size_t)mod_row(r) * NMOD + le * 4;
        unsigned hw[8];
#pragma unroll
        for (int q = 0; q < 4; ++q) { const f32x4 sh = *(const f32x4*)(mdn + 256 * q), sc = *(const f32x4*)(mdn + D + 256 * q);
            const float y0 = v[4 * q] * rstd * (1.f + sc.x) + sh.x, y1 = v[4 * q + 1] * rstd * (1.f + sc.y) + sh.y, y2 = v[4 * q + 2] * rstd * (1.f + sc.z) + sh.z, y3 = v[4 * q + 3] * rstd * (1.f + sc.w) + sh.w;
            hw[2 * q] = pk2(y0, y1); hw[2 * q + 1] = pk2(y2, y3); }
        bf16_t* ho = HBFw + (size_t)r * D + le * 4;
#pragma unroll
        for (int q = 0; q < 4; ++q) { u32x2 w; w.x = hw[2 * q]; w.y = hw[2 * q + 1]; *(u32x2*)(ho + 256 * q) = w; }
        float gp[16];
#pragma unroll
        for (int jg = 0; jg < 16; ++jg) { float a = 0.f;
#pragma unroll
            for (int q = 0; q < 4; ++q) { const f32x4 wv = *(const LAS f32x4*)(lds + (jg * D + 256 * q) * 4 + le * 16);
                a += bflo(hw[2 * q]) * wv.x + bfhi(hw[2 * q]) * wv.y + bflo(hw[2 * q + 1]) * wv.z + bfhi(hw[2 * q + 1]) * wv.w; }
            gp[jg] = a; }
        treduce_stepm<16, 1>(gp, lane); treduce_stepm<8, 2>(gp, lane); treduce_stepm<4, 4>(gp, lane); treduce_stepm<2, 8>(gp, lane);
        float gs = gp[0]; gs += xshfl<16>(gs); gs += xshfl<32>(gs);
        if (le < 16) { const int jg = bitrev4(le); GATE[(size_t)r * 16 + jg] = gs + SMF(A.ws, SM_MLBIN)[3072 + jg]; }
    }
}

__device__ __forceinline__ void peer_apply_phase(const Args& A, LAS unsigned char* lds, int wave, int layer, int nrows, bool last, int gw, int NGW, int lane) { peer_apply_phase_t<0>(A, lds, wave, layer, nrows, last, gw, NGW, lane); }
#undef MK_HAVE_P3
#define MK_HAVE_P3 1
#include <hip/hip_bf16.h>
#include <cmath>
namespace attn_body {
using bf16=__hip_bfloat16;
using bf16x8=__attribute__((ext_vector_type(8)))short;
using s16x4=__attribute__((ext_vector_type(4)))short;
using f32x16=__attribute__((ext_vector_type(16)))float;
using u32x4=__attribute__((ext_vector_type(4)))unsigned;
constexpr int D=64,QPITCH=512,KVPITCH=128,OPITCH=1024;
constexpr int NW=8,QBLK=32,QB=QBLK*NW,KVBLK=64;
__device__ __forceinline__ int crow(int r,int hi){return (r&3)+8*(r>>2)+4*hi;}
#define SBAR() __builtin_amdgcn_sched_barrier(0)
constexpr int NSLOT=3, SLOTB=8192;
constexpr int LDS_K=0, LDS_V=NSLOT*SLOTB, LDS_WS=2*NSLOT*SLOTB, LDS_OST=LDS_WS+NW*64*4, LDS_BYTES=LDS_OST+NW*4096;
constexpr float C2=0.125f*1.4426950408889634f;
__device__ __forceinline__ void glds16(const void*gsrc,unsigned lds_dst){unsigned keep;
  asm volatile("s_mov_b32 %0, m0\n\ts_mov_b32 m0, %2\n\ts_nop 0\n\tglobal_load_lds_dwordx4 %1, off\n\ts_mov_b32 m0, %0":"=&s"(keep):"v"(gsrc),"s"(lds_dst):"memory");}
__device__ __forceinline__ float max3f(float a,float b,float c){float r;asm("v_max3_f32 %0, %1, %2, %3":"=v"(r):"v"(a),"v"(b),"v"(c));return r;}
__device__ __forceinline__ float max2f(float a,float b){float r;asm("v_max_f32_e32 %0, %1, %2":"=v"(r):"v"(a),"v"(b));return r;}
__device__ __forceinline__ float fadd_s(float a,float b){float r;asm("v_add_f32_e32 %0, %1, %2":"=v"(r):"v"(a),"v"(b));return r;}
__device__ __forceinline__ float fsub_s(float a,float b){float r;asm("v_sub_f32_e32 %0, %1, %2":"=v"(r):"v"(a),"v"(b));return r;}
typedef float f32x2_t __attribute__((ext_vector_type(2))); typedef __bf16 bf16x2_t __attribute__((ext_vector_type(2)));
__device__ __forceinline__ unsigned cvtpk_s(float lo,float hi){f32x2_t v={lo,hi};bf16x2_t b=__builtin_convertvector(v,bf16x2_t);return __builtin_bit_cast(unsigned,b);}
#define WAIT_BAR(N) asm volatile("s_waitcnt vmcnt(" #N ") lgkmcnt(0)\n\ts_barrier":::"memory")

__device__ __forceinline__ void qkt(f32x16&p0,f32x16&p1,const char*Kslot,const bf16x8*qr,const f32x16&negm,int r32,int hi){
  const char*kb=Kslot+hi*1024+r32*16;
  #pragma unroll
  for(int d0=0;d0<4;++d0){
    const bf16x8 b0=*reinterpret_cast<const bf16x8*>(kb+d0*2048);
    const bf16x8 b1=*reinterpret_cast<const bf16x8*>(kb+d0*2048+512);
    if(d0==0){p0=__builtin_amdgcn_mfma_f32_32x32x16_bf16(b0,qr[0],negm,0,0,0);p1=__builtin_amdgcn_mfma_f32_32x32x16_bf16(b1,qr[0],negm,0,0,0);}
    else{p0=__builtin_amdgcn_mfma_f32_32x32x16_bf16(b0,qr[d0],p0,0,0,0);p1=__builtin_amdgcn_mfma_f32_32x32x16_bf16(b1,qr[d0],p1,0,0,0);}}
}
typedef __attribute__((address_space(3))) const char* lds_cptr;
typedef short v4i16_t __attribute__((ext_vector_type(4)));
__device__ __forceinline__ void kload8(bf16x8*kf,lds_cptr kp){
  kf[0]=*(const __attribute__((address_space(3))) bf16x8*)(kp);      kf[1]=*(const __attribute__((address_space(3))) bf16x8*)(kp+512);
  kf[2]=*(const __attribute__((address_space(3))) bf16x8*)(kp+2048); kf[3]=*(const __attribute__((address_space(3))) bf16x8*)(kp+2560);
  kf[4]=*(const __attribute__((address_space(3))) bf16x8*)(kp+4096); kf[5]=*(const __attribute__((address_space(3))) bf16x8*)(kp+4608);
  kf[6]=*(const __attribute__((address_space(3))) bf16x8*)(kp+6144); kf[7]=*(const __attribute__((address_space(3))) bf16x8*)(kp+6656);
}
__device__ __forceinline__ void kload2(bf16x8*kf,lds_cptr kp,int j){ kf[2*j]=*(const __attribute__((address_space(3))) bf16x8*)(kp+j*2048); kf[2*j+1]=*(const __attribute__((address_space(3))) bf16x8*)(kp+j*2048+512); }
__device__ __forceinline__ s16x4 vtr(lds_cptr p){ return __builtin_bit_cast(s16x4,__builtin_amdgcn_ds_read_tr16_b64_v4i16((__attribute__((address_space(3))) v4i16_t*)p)); }
__device__ __forceinline__ float rowmax(const f32x16&p0,const f32x16&p1){
  float a=max3f(p0[0],p0[1],p1[0]),b=max3f(p0[2],p0[3],p1[1]);a=max3f(a,p1[2],p1[3]);
  #pragma unroll
  for(int r=4;r<16;r+=4){a=max3f(a,p0[r],p0[r+1]);b=max3f(b,p0[r+2],p0[r+3]);a=max3f(a,p1[r],p1[r+1]);b=max3f(b,p1[r+2],p1[r+3]);}
  const float m=max2f(a,b);
  auto rr=__builtin_amdgcn_permlane32_swap(__float_as_uint(m),__float_as_uint(m),false,false);
  return max2f(__uint_as_float(rr[0]),__uint_as_float(rr[1]));
}
__device__ __forceinline__ void pv(f32x16*o,int vb,bf16x8 pa0,bf16x8 pa1,bf16x8 pa2,bf16x8 pa3){
  #pragma unroll
  for(int d0=0;d0<2;++d0){s16x4 lo[4],hi[4];
    #pragma unroll
    for(int ks=0;ks<4;++ks){
      asm volatile("ds_read_b64_tr_b16 %0,%1 offset:%c2":"=&v"(lo[ks]):"v"(vb),"i"(d0*4096+ks*1024):"memory");
      asm volatile("ds_read_b64_tr_b16 %0,%1 offset:%c2":"=&v"(hi[ks]):"v"(vb),"i"(d0*4096+ks*1024+512):"memory");}
    asm volatile("s_waitcnt lgkmcnt(0)":::"memory");SBAR();
    #define PK(k) (bf16x8){lo[k][0],lo[k][1],lo[k][2],lo[k][3],hi[k][0],hi[k][1],hi[k][2],hi[k][3]}
    o[d0]=__builtin_amdgcn_mfma_f32_32x32x16_bf16(pa0,PK(0),o[d0],0,0,0);
    o[d0]=__builtin_amdgcn_mfma_f32_32x32x16_bf16(pa1,PK(1),o[d0],0,0,0);
    o[d0]=__builtin_amdgcn_mfma_f32_32x32x16_bf16(pa2,PK(2),o[d0],0,0,0);
    o[d0]=__builtin_amdgcn_mfma_f32_32x32x16_bf16(pa3,PK(3),o[d0],0,0,0);
    #undef PK
  }
}
#ifndef ATTN_STORE16
#define ATTN_STORE16(p,v) (*(u32x4*)(p)=(v))
#endif
template<int THRL> __device__ __forceinline__ void attn_unit(const bf16*Qu,const bf16*__restrict__ Kh,const bf16*__restrict__ Vh,bf16*Ou,const int NT,char*shm,const int wid){
  const int lane=fresh_lane(),r32=lane&31,hi=lane>>5;
  const bf16*Qw=Qu+(long)(wid*QBLK)*QPITCH;
  const unsigned lds0=(unsigned)(uintptr_t)shm;
  float*wsf=(float*)(shm+LDS_WS)+wid*64;
  const bf16*ksrc=Kh+(long)lane*KVPITCH+wid*8;
  const bf16*vsrc=Vh+(long)(16*(wid&3)+(lane>>2))*KVPITCH+(wid>>2)*32+(lane&3)*8;
  const unsigned kdst=lds0+LDS_K+wid*1024, vdst=lds0+LDS_V+wid*1024;
  #define DMA_K(t,slot) glds16(ksrc+(long)(t)*KVBLK*KVPITCH,(unsigned)__builtin_amdgcn_readfirstlane(kdst+(slot)))
  #define DMA_V(t,slot) glds16(vsrc+(long)(t)*KVBLK*KVPITCH,(unsigned)__builtin_amdgcn_readfirstlane(vdst+(slot)))
  const int vb0=(int)(lds0+LDS_V)+((lane>>4)&1)*32+(lane&3)*8+(4*hi+((lane&15)>>2))*64;
  const char*Kbase=shm+LDS_K; bf16x8 kf[8];
  const lds_cptr shm3=(lds_cptr)shm; const lds_cptr kp0=shm3+LDS_K+hi*1024+r32*16; const lds_cptr vp0=shm3+LDS_V+((lane>>4)&1)*32+(lane&3)*8+(4*hi+((lane&15)>>2))*64;
  DMA_K(0,0);DMA_V(0,0);DMA_K(1,SLOTB);
  bf16x8 qr[4];
  #pragma unroll
  for(int d0=0;d0<4;++d0)qr[d0]=*reinterpret_cast<const bf16x8*>(&Qw[(long)r32*QPITCH+d0*16+hi*8]);
  float mhat=0.f,l_reg=0.f;f32x16 o[2];o[0]=f32x16{};o[1]=f32x16{};f32x16 negm=f32x16{};asm volatile("":"+v"(negm));
  #define CMASK(P0,P1,t) do{}while(0)
  bool resc=false;
  #define START(P0,P1) do{ const float rm=rowmax(P0,P1); resc=false; \
    { const float dl=rm; mhat=fadd_s(mhat,dl); \
      _Pragma("unroll") for(int r=0;r<16;++r){P0[r]=fsub_s(P0[r],dl);P1[r]=fsub_s(P1[r],dl);} \
      _Pragma("unroll") for(int r=0;r<16;++r)negm[r]=-mhat; asm volatile("":"+v"(negm)); } \
    _Pragma("unroll") for(int r=0;r<16;++r)P0[r]=__builtin_amdgcn_exp2f(P0[r]); }while(0)
  #define RESC() do{ if(resc){ asm volatile("s_waitcnt lgkmcnt(0)":::"memory"); \
      _Pragma("unroll") for(int d_=0;d_<2;++d_) _Pragma("unroll") for(int r=0;r<16;++r)o[d_][r]*=wsf[crow(r,hi)]; } }while(0)
  f32x16 pA0,pA1,pB0,pB1;
  int sl_prev=0,sl_cur=0,sl_next=SLOTB;
  #define ROT() do{sl_prev=sl_cur;sl_cur=sl_next;sl_next=(sl_next==(NSLOT-1)*SLOTB)?0:sl_next+SLOTB;}while(0)
  DMA_K(2,2*SLOTB);
  WAIT_BAR(3);
  qkt(pA0,pA1,Kbase,qr,negm,r32,hi);asm volatile("s_nop 15\n\ts_nop 7":"+v"(pA0),"+v"(pA1));CMASK(pA0,pA1,0);
  START(pA0,pA1);
  _Pragma("unroll") for(int r=0;r<16;++r)pA1[r]=__builtin_amdgcn_exp2f(pA1[r]);
  WAIT_BAR(0);
  DMA_K(3,0);DMA_V(1,SLOTB);
  ROT();
  kload8(kf,kp0+sl_cur);
  WAIT_BAR(2);
  s16x4 vlo[8],vhi[8]; u32x4 pw0,pw1,pw2,pw3;
  #define PKW(P,B) cvtpk_s(P[B],P[B+1])
  #define PAF(k) __builtin_bit_cast(bf16x8,pw##k)
  #define VFR(i) (bf16x8){vlo[i][0],vlo[i][1],vlo[i][2],vlo[i][3],vhi[i][0],vhi[i][1],vhi[i][2],vhi[i][3]}
  #define PIN(x) asm volatile("":"+v"(x))
  #define MX3(a,b,c) __builtin_fmaxf(__builtin_fmaxf((a),(b)),(c))
  #define GAPA(MF,A0,A1,A2,A3,W0,W1,PW) do{ MF; sacc+=A0; sacc+=A1; sacc+=A2; sacc+=A3; PIN(sacc); W0; W1; PIN(PW); SBAR(); }while(0)
  #define EX(v) __builtin_amdgcn_exp2f(v)
  #define GAPB(MF,X,B) do{ MF; X[B]=EX(X[B]); X[B+1]=EX(X[B+1]); X[B+2]=EX(X[B+2]); X[B+3]=EX(X[B+3]); PIN(X); SBAR(); }while(0)
  #define VRD(i) do{ vlo[i]=vtr(vp_+(((i)>>2)*4096+((i)&3)*1024)); vhi[i]=vtr(vp_+(((i)>>2)*4096+((i)&3)*1024+512)); }while(0)
  #define KRD(G,j) do{ if(G){ kload2(kf,kp0+sl_next,j); SBAR(); } }while(0)
  #define STEP(C0,C1,P0,P1,t,GK,GV,GL) do{ SBAR(); \
    const lds_cptr vp_=vp0+sl_prev; \
    VRD(0); SBAR(); float sacc=(P0[0]+P0[1]); \
    GAPA(C0=__builtin_amdgcn_mfma_f32_32x32x16_bf16(kf[0],qr[0],negm,0,0,0), P0[2],P0[3],P0[4],P0[5],     pw0[0]=PKW(P0,0), pw0[1]=PKW(P0,2), pw0); \
    VRD(4); SBAR(); GAPA(C1=__builtin_amdgcn_mfma_f32_32x32x16_bf16(kf[1],qr[0],negm,0,0,0), P0[6],P0[7],P0[8],P0[9],     pw0[2]=PKW(P0,4), pw0[3]=PKW(P0,6), pw0); \
    VRD(1); SBAR(); GAPA(C0=__builtin_amdgcn_mfma_f32_32x32x16_bf16(kf[2],qr[1],C0,0,0,0),   P0[10],P0[11],P0[12],P0[13], pw1[0]=PKW(P0,8), pw1[1]=PKW(P0,10), pw1); \
    VRD(5); SBAR(); GAPA(C1=__builtin_amdgcn_mfma_f32_32x32x16_bf16(kf[3],qr[1],C1,0,0,0),   P0[14],P0[15],P1[0],P1[1],   pw1[2]=PKW(P0,12),pw1[3]=PKW(P0,14), pw1); \
    VRD(2); SBAR(); GAPA(C0=__builtin_amdgcn_mfma_f32_32x32x16_bf16(kf[4],qr[2],C0,0,0,0),   P1[2],P1[3],P1[4],P1[5],     pw2[0]=PKW(P1,0), pw2[1]=PKW(P1,2), pw2); \
    VRD(6); SBAR(); GAPA(C1=__builtin_amdgcn_mfma_f32_32x32x16_bf16(kf[5],qr[2],C1,0,0,0),   P1[6],P1[7],P1[8],P1[9],     pw2[2]=PKW(P1,4), pw2[3]=PKW(P1,6), pw2); \
    VRD(3); SBAR(); GAPA(C0=__builtin_amdgcn_mfma_f32_32x32x16_bf16(kf[6],qr[3],C0,0,0,0),   P1[10],P1[11],P1[12],P1[13], pw3[0]=PKW(P1,8), pw3[1]=PKW(P1,10), pw3); \
    VRD(7); SBAR(); GAPA(C1=__builtin_amdgcn_mfma_f32_32x32x16_bf16(kf[7],qr[3],C1,0,0,0),   P1[14],P1[15],0.f,0.f,       pw3[2]=PKW(P1,12),pw3[3]=PKW(P1,14), pw3); \
    l_reg+=sacc; \
    if(GK){DMA_K((t)+3,sl_cur);} if(GV){DMA_V((t)+1,sl_next);} \
    CMASK(C0,C1,t); \
    { float a=MX3(C0[0],C0[1],C1[0]),b=MX3(C0[2],C0[3],C1[1]); a=MX3(a,C1[2],C1[3]); \
      _Pragma("unroll") for(int r=4;r<16;r+=4){a=MX3(a,C0[r],C0[r+1]);b=MX3(b,C0[r+2],C0[r+3]);a=MX3(a,C1[r],C1[r+1]);b=MX3(b,C1[r+2],C1[r+3]);} \
      float rm=__builtin_fmaxf(a,b); { auto rr=__builtin_amdgcn_permlane32_swap(__float_as_uint(rm),__float_as_uint(rm),false,false); rm=__builtin_fmaxf(__uint_as_float(rr[0]),__uint_as_float(rr[1])); } \
      resc=false; \
      if(__builtin_expect(__any(rm>(float)THRL),0)){ const float dl=__builtin_fmaxf(rm,0.f); mhat+=dl; \
        _Pragma("unroll") for(int r=0;r<16;++r){C0[r]-=dl;C1[r]-=dl;} \
        _Pragma("unroll") for(int r=0;r<16;++r)negm[r]=-mhat; asm volatile("":"+v"(negm)); \
        const float f=__builtin_amdgcn_exp2f(-dl); l_reg*=f; if(hi==0)wsf[r32]=f; resc=true; } } \
    SBAR(); \
    GAPB(o[0]=__builtin_amdgcn_mfma_f32_32x32x16_bf16(PAF(0),VFR(0),o[0],0,0,0), C0,0); \
    GAPB(o[1]=__builtin_amdgcn_mfma_f32_32x32x16_bf16(PAF(0),VFR(4),o[1],0,0,0), C0,4); \
    KRD(GL,0); GAPB(o[0]=__builtin_amdgcn_mfma_f32_32x32x16_bf16(PAF(1),VFR(1),o[0],0,0,0), C0,8); \
    KRD(GL,1); GAPB(o[1]=__builtin_amdgcn_mfma_f32_32x32x16_bf16(PAF(1),VFR(5),o[1],0,0,0), C0,12); \
    KRD(GL,2); GAPB(o[0]=__builtin_amdgcn_mfma_f32_32x32x16_bf16(PAF(2),VFR(2),o[0],0,0,0), C1,0); \
    KRD(GL,3); GAPB(o[1]=__builtin_amdgcn_mfma_f32_32x32x16_bf16(PAF(2),VFR(6),o[1],0,0,0), C1,4); \
    GAPB(o[0]=__builtin_amdgcn_mfma_f32_32x32x16_bf16(PAF(3),VFR(3),o[0],0,0,0), C1,8); \
    GAPB(o[1]=__builtin_amdgcn_mfma_f32_32x32x16_bf16(PAF(3),VFR(7),o[1],0,0,0), C1,12); \
    }while(0)
  int t=1;
  #undef CMASK
  #define CMASK(P0,P1,t) do{}while(0)
  for(;t+5<NT;t+=2){
    STEP(pB0,pB1,pA0,pA1,t,true,true,true);     WAIT_BAR(2); RESC(); ROT();
    STEP(pA0,pA1,pB0,pB1,t+1,true,true,true);   WAIT_BAR(2); RESC(); ROT();
  }
  #undef CMASK
  #define CMASK(P0,P1,t) do{}while(0)
  #define ENDW(tt) do{ if((tt)+3<NT){WAIT_BAR(2);} else if((tt)+2<NT){WAIT_BAR(1);} else {WAIT_BAR(0);} }while(0)
  for(;t+1<NT;t+=2){
    STEP(pB0,pB1,pA0,pA1,t,(t+3<NT),(t+1<NT),(t+1<NT));       ENDW(t);   RESC(); ROT();
    STEP(pA0,pA1,pB0,pB1,t+1,(t+4<NT),(t+2<NT),(t+2<NT));     ENDW(t+1); RESC(); ROT();
  }
  STEP(pB0,pB1,pA0,pA1,NT-1,false,false,false); RESC();
  { float sacc=pB0[0]+pB0[1]; _Pragma("unroll") for(int r=2;r<16;++r)sacc+=pB0[r]; _Pragma("unroll") for(int r=0;r<16;++r)sacc+=pB1[r]; l_reg+=sacc;
    pw0=(u32x4){PKW(pB0,0),PKW(pB0,2),PKW(pB0,4),PKW(pB0,6)};pw1=(u32x4){PKW(pB0,8),PKW(pB0,10),PKW(pB0,12),PKW(pB0,14)};pw2=(u32x4){PKW(pB1,0),PKW(pB1,2),PKW(pB1,4),PKW(pB1,6)};pw3=(u32x4){PKW(pB1,8),PKW(pB1,10),PKW(pB1,12),PKW(pB1,14)};
    SBAR(); pv(o,vb0+sl_cur,PAF(0),PAF(1),PAF(2),PAF(3)); }
  #undef PKW
  #undef PAF
  #undef VFR
  #undef PIN
  #undef MX3
  #undef GAPA
  #undef GAPB
  #undef EX
  #undef VRD
  #undef KRD
  #undef STEP
  #undef ENDW
  {auto rr=__builtin_amdgcn_permlane32_swap(__float_as_uint(l_reg),__float_as_uint(l_reg),false,false);l_reg=__uint_as_float(rr[0])+__uint_as_float(rr[1]);}
  if(hi==0)wsf[32+r32]=l_reg;asm volatile("s_waitcnt lgkmcnt(0)":::"memory");
  float rli[16];
  #pragma unroll
  for(int r=0;r<16;++r)rli[r]=__builtin_amdgcn_rcpf(wsf[32+crow(r,hi)]);
  bf16*Ow=Ou+(long)(wid*QBLK)*OPITCH;
  { bf16*stg=(bf16*)(shm+LDS_OST)+wid*2048;
    #pragma unroll
    for(int r=0;r<16;++r){const int orow=crow(r,hi);
      #pragma unroll
      for(int d0=0;d0<2;++d0)stg[orow*64+d0*32+r32]=__float2bfloat16(o[d0][r]*rli[r]);}
    asm volatile("s_waitcnt lgkmcnt(0)":::"memory");
    #pragma unroll
    for(int i=0;i<4;++i){const int row=i*8+(lane>>3),ch=lane&7; const u32x4 v=*(const u32x4*)(stg+row*64+ch*8); ATTN_STORE16(Ow+(long)row*OPITCH+ch*8,v);} }
  asm volatile("s_waitcnt lgkmcnt(0)\n\ts_barrier":::"memory");
  #undef DMA_K
  #undef DMA_V
  #undef CMASK
  #undef START
  #undef RESC
  #undef ROT
}
constexpr int ATTN_LDS_BYTES=LDS_BYTES;
#undef SBAR
#undef WAIT_BAR
}

template <int ABL3>
__device__ __forceinline__ void p3_attn_conv_t(const Args& A, unsigned char* lds_raw, int vcu, int G, int wave) {
    typedef attn_body::bf16 abf;
    const abf* Q = (const abf*)(A.ws + WS_Q); const abf* K = (const abf*)(A.ws + WS_K); const abf* V = (const abf*)(A.ws + WS_V); abf* Y = (abf*)(A.ws + WS_YBF);
    if (ABL3 != 1) for (int u = vcu; u < 576; u += G) {
        const abf *Qu, *Kh, *Vh; abf* Ou; int NT;
        if (u < 512) { const int b = u >> 6, h = (u >> 3) & 7, qb = u & 7; const size_t row = (size_t)b * SEQ + qb * 256;
            Qu = Q + row * 512 + h * 64; Ou = Y + row * 1024 + 512 + h * 64; Kh = K + (size_t)b * KVLEN * 128 + (h >> 2) * 64; Vh = V + (size_t)b * KVLEN * 128 + (h >> 2) * 64; NT = KVLEN / 64; }
        else { const int uu = u - 512, b = uu >> 3, h = uu & 7; const size_t row = (size_t)TL + b * CTX;
            Qu = Q + row * 512 + h * 64; Ou = Y + row * 1024 + 512 + h * 64; Kh = K + (size_t)b * KVLEN * 128 + (h >> 2) * 64; Vh = V + (size_t)b * KVLEN * 128 + (h >> 2) * 64; NT = CTX / 64; }
        attn_body::attn_unit<8>(Qu, Kh, Vh, Ou, NT, (char*)lds_raw, wave);
    }
    LAS unsigned char* lds = (LAS unsigned char*)lds_raw;
    const int lane = fresh_lane(), tid = wave * 64 + lane;
    const bf16_t* GLU = (const bf16_t*)(A.ws + WS_GLU); bf16_t* YB = (bf16_t*)(A.ws + WS_YBF);
    constexpr int CW_OFF = 0, CX_OFF = 32768, SUB = 18;
    __syncthreads();
    if (ABL3 != 2) { u32x4 wv[4];
#pragma unroll
        for (int it = 0; it < 4; ++it) wv[it] = ((const u32x4*)(A.ws + WS_MISC + SM_W2))[tid + it * NTHR];
#pragma unroll
        for (int it = 0; it < 4; ++it) ((LAS u32x4*)(lds + CW_OFF))[tid + it * NTHR] = wv[it]; }
    const int rows_per = (TT + G - 1) / G, r0 = vcu * rows_per, r1 = (r0 + rows_per < TT) ? r0 + rows_per : TT;
    const f32x4 cb0 = *(const f32x4*)(SMF(A.ws, SM_CONVB) + lane * 8), cb1 = *(const f32x4*)(SMF(A.ws, SM_CONVB) + lane * 8 + 4);
    const f32x4 g0 = *(const f32x4*)(SMF(A.ws, SM_CLNG) + lane * 8), g1 = *(const f32x4*)(SMF(A.ws, SM_CLNG) + lane * 8 + 4), c0 = *(const f32x4*)(SMF(A.ws, SM_CLNB) + lane * 8), c1 = *(const f32x4*)(SMF(A.ws, SM_CLNB) + lane * 8 + 4);
    if (ABL3 != 2) for (int s0 = r0; s0 < r1; s0 += SUB) {
        const int s1 = (s0 + SUB < r1) ? s0 + SUB : r1, base = s0 - 15, nst = (s1 - s0) + 29;
        __syncthreads();
        { u32x4 xa[6], xb[6];
#pragma unroll
          for (int it = 0; it < 6; ++it) { const int i = tid + it * NTHR, rr = base + (i >> 6), ch = i & 63; xa[it] = u32x4{0u, 0u, 0u, 0u}; xb[it] = u32x4{0u, 0u, 0u, 0u};
              if (i < nst * 64) { if (rr >= 0 && rr < TT) xa[it] = *(const u32x4*)(GLU + (size_t)rr * 512 + ch * 8);
                                  if (rr + 1 >= 0 && rr + 1 < TT) xb[it] = *(const u32x4*)(GLU + (size_t)(rr + 1) * 512 + ch * 8); } }
#pragma unroll
          for (int it = 0; it < 6; ++it) { const int i = tid + it * NTHR, ch = i & 63;
              if (i < nst * 64) { u32x4 o0, o1;
                  o0.x = (xa[it].x & 0xffffu) | (xb[it].x << 16); o0.y = (xa[it].x >> 16) | (xb[it].x & 0xffff0000u); o0.z = (xa[it].y & 0xffffu) | (xb[it].y << 16); o0.w = (xa[it].y >> 16) | (xb[it].y & 0xffff0000u);
                  o1.x = (xa[it].z & 0xffffu) | (xb[it].z << 16); o1.y = (xa[it].z >> 16) | (xb[it].z & 0xffff0000u); o1.z = (xa[it].w & 0xffffu) | (xb[it].w << 16); o1.w = (xa[it].w >> 16) | (xb[it].w & 0xffff0000u);
                  LAS u32x4* dst = (LAS u32x4*)(lds + CX_OFF + (i >> 6) * 2048 + ch * 32); dst[0] = o0; dst[1] = o1; } } }
        __syncthreads();
        for (int r = s0 + wave; r < s1; r += NWAVES) {
            int lo, hi; if (r < TL) { lo = r & ~(SEQ - 1); hi = lo + SEQ; } else { lo = TL + ((r - TL) & ~(CTX - 1)); hi = lo + CTX; }
            float acc[8];
            acc[0] = cb0.x; acc[1] = cb0.y; acc[2] = cb0.z; acc[3] = cb0.w; acc[4] = cb1.x; acc[5] = cb1.y; acc[6] = cb1.z; acc[7] = cb1.w;
#pragma unroll 4
            for (int jp = 0; jp < 16; ++jp) { const int rr = r + 2 * jp - 15;
                const bool v0 = rr >= lo && rr < hi, v1 = rr + 1 >= lo && rr + 1 < hi;
                if (!v0 && !v1) continue;
                const unsigned wm = (v0 ? 0x0000ffffu : 0u) | (v1 ? 0xffff0000u : 0u);
                const LAS u32x4* xp = (const LAS u32x4*)(lds + CX_OFF + (rr - base) * 2048 + lane * 32); const LAS u32x4* wp = (const LAS u32x4*)(lds + CW_OFF + jp * 2048 + lane * 32);
                const u32x4 x0 = xp[0], x1 = xp[1], w0 = wp[0], w1 = wp[1];
                acc[0] = dot2bf(x0.x, w0.x & wm, acc[0]); acc[1] = dot2bf(x0.y, w0.y & wm, acc[1]); acc[2] = dot2bf(x0.z, w0.z & wm, acc[2]); acc[3] = dot2bf(x0.w, w0.w & wm, acc[3]);
                acc[4] = dot2bf(x1.x, w1.x & wm, acc[4]); acc[5] = dot2bf(x1.y, w1.y & wm, acc[5]); acc[6] = dot2bf(x1.z, w1.z & wm, acc[6]); acc[7] = dot2bf(x1.w, w1.w & wm, acc[7]); }
            float s = 0.f;
#pragma unroll
            for (int i = 0; i < 8; ++i) s += acc[i];
            const float mu = wsum(s) * (1.f / 512.f); float s2 = 0.f;
#pragma unroll
            for (int i = 0; i < 8; ++i) { acc[i] -= mu; s2 += acc[i] * acc[i]; }
            const float rstd = rsqrtf(wsum(s2) * (1.f / 512.f) + EPS);
            float y[8];
            y[0] = acc[0] * rstd * g0.x + c0.x; y[1] = acc[1] * rstd * g0.y + c0.y; y[2] = acc[2] * rstd * g0.z + c0.z; y[3] = acc[3] * rstd * g0.w + c0.w;
            y[4] = acc[4] * rstd * g1.x + c1.x; y[5] = acc[5] * rstd * g1.y + c1.y; y[6] = acc[6] * rstd * g1.z + c1.z; y[7] = acc[7] * rstd * g1.w + c1.w;
#pragma unroll
            for (int i = 0; i < 8; ++i) y[i] = y[i] * sigmoidf_(y[i]);
            u32x4 o; o.x = pk2(y[0], y[1]); o.y = pk2(y[2], y[3]); o.z = pk2(y[4], y[5]); o.w = pk2(y[6], y[7]);
            *(u32x4*)(YB + (size_t)r * D + lane * 8) = o;
        }
    }
    __syncthreads();
}

__device__ __forceinline__ void p3_attn_conv(const Args& A, unsigned char* lds_raw, int vcu, int G, int wave) { p3_attn_conv_t<0>(A, lds_raw, vcu, G, wave); }
#undef MK_HAVE_P7
#define MK_HAVE_P7 1
namespace topk {
typedef short bf16x8 __attribute__((ext_vector_type(8)));
typedef float f32x16 __attribute__((ext_vector_type(16)));
constexpr int KROW = 272;
constexpr int LDS_K1 = 0, LDS_K2 = 128 * KROW, LDS_TAB = 2 * 128 * KROW, LDS_IDX = LDS_TAB + 256;
__device__ __forceinline__ int f2key(float f, int idx, int mask) { return (__float_as_int(f) & ~mask) | idx; }
__device__ __forceinline__ int key2bits(int k) { return k; }
__device__ __forceinline__ int kmax(int a, int b) { int r; asm("v_max_f32 %0, %1, %2" : "=v"(r) : "v"(a), "v"(b)); return r; }
__device__ __forceinline__ int kmin(int a, int b) { int r; asm("v_min_f32 %0, %1, %2" : "=v"(r) : "v"(a), "v"(b)); return r; }
__device__ __forceinline__ void ce_desc(int& a, int& b) { const int hi = kmax(a, b), lo = kmin(a, b); a = hi; b = lo; }
template <int N> __device__ __forceinline__ void bitonic_sort_desc(int (&v)[N]) {
#pragma unroll
    for (int k = 2; k <= N; k <<= 1)
#pragma unroll
        for (int j = k >> 1; j > 0; j >>= 1)
#pragma unroll
            for (int i = 0; i < N; ++i) { const int l = i ^ j; if (l > i) { if ((i & k) == 0) ce_desc(v[i], v[l]); else ce_desc(v[l], v[i]); } }
}
template <int N> __device__ __forceinline__ void bitonic_merge_desc(int (&v)[N]) {
#pragma unroll
    for (int j = N >> 1; j > 0; j >>= 1)
#pragma unroll
        for (int i = 0; i < N; ++i) { const int l = i ^ j; if (l > i) ce_desc(v[i], v[l]); }
}
__device__ __forceinline__ void sort16_desc(int (&v)[16]) {
    ce_desc(v[0], v[13]); ce_desc(v[1], v[12]); ce_desc(v[2], v[15]); ce_desc(v[3], v[14]); ce_desc(v[4], v[8]); ce_desc(v[5], v[6]); ce_desc(v[7], v[11]); ce_desc(v[9], v[10]);
    ce_desc(v[0], v[5]); ce_desc(v[1], v[7]); ce_desc(v[2], v[9]); ce_desc(v[3], v[4]); ce_desc(v[6], v[13]); ce_desc(v[8], v[14]); ce_desc(v[10], v[15]); ce_desc(v[11], v[12]);
    ce_desc(v[0], v[1]); ce_desc(v[2], v[3]); ce_desc(v[4], v[5]); ce_desc(v[6], v[8]); ce_desc(v[7], v[9]); ce_desc(v[10], v[11]); ce_desc(v[12], v[13]); ce_desc(v[14], v[15]);
    ce_desc(v[0], v[2]); ce_desc(v[1], v[3]); ce_desc(v[4], v[10]); ce_desc(v[5], v[11]); ce_desc(v[6], v[7]); ce_desc(v[8], v[9]); ce_desc(v[12], v[14]); ce_desc(v[13], v[15]);
    ce_desc(v[1], v[2]); ce_desc(v[3], v[12]); ce_desc(v[4], v[6]); ce_desc(v[5], v[7]); ce_desc(v[8], v[10]); ce_desc(v[9], v[11]); ce_desc(v[13], v[14]);
    ce_desc(v[1], v[4]); ce_desc(v[2], v[6]); ce_desc(v[5], v[8]); ce_desc(v[7], v[10]); ce_desc(v[9], v[13]); ce_desc(v[11], v[14]);
    ce_desc(v[2], v[4]); ce_desc(v[3], v[6]); ce_desc(v[9], v[12]); ce_desc(v[11], v[13]);
    ce_desc(v[3], v[5]); ce_desc(v[6], v[8]); ce_desc(v[7], v[9]); ce_desc(v[10], v[12]);
    ce_desc(v[3], v[4]); ce_desc(v[5], v[6]); ce_desc(v[7], v[8]); ce_desc(v[9], v[10]); ce_desc(v[11], v[12]);
    ce_desc(v[6], v[7]); ce_desc(v[8], v[9]);
}
__device__ __forceinline__ void merge_top16(int (&a)[16], const int (&b)[16]) {
#pragma unroll
    for (int i = 0; i < 16; ++i) a[i] = kmax(a[i], b[15 - i]);
    bitonic_merge_desc<16>(a);
}
__device__ __forceinline__ void top16_of_64(int (&g0)[16], int (&g1)[16], int (&g2)[16], int (&g3)[16]) {
    sort16_desc(g0); sort16_desc(g1); sort16_desc(g2); sort16_desc(g3);
    merge_top16(g0, g1); merge_top16(g2, g3); merge_top16(g0, g2);
}
__host__ __device__ constexpr int cand_a(int li) {
    int cnt = 0;
    for (int a = 0; a < 16; ++a) for (int b = 0; b < 16; ++b) if ((a + 1) * (b + 1) <= 16) { if (cnt == li) return a; ++cnt; }
    return 0;
}
__host__ __device__ constexpr int cand_b(int li) {
    int cnt = 0;
    for (int a = 0; a < 16; ++a) for (int b = 0; b < 16; ++b) if ((a + 1) * (b + 1) <= 16) { if (cnt == li) return b; ++cnt; }
    return 0;
}
template <int I> struct CandFill {
    static __device__ __forceinline__ void run(int (&c)[32], const float (&v1)[16], const float (&v2)[16], bool hi) {
        constexpr int lo_i = I, hi_i = 32 + I, hi_c = hi_i < 50 ? hi_i : 0;
        constexpr int alo = cand_a(lo_i), blo = cand_b(lo_i), ahi = cand_a(hi_c), bhi = cand_b(hi_c);
        const float slo = v1[alo] + v2[blo];
        const float shi = hi_i < 50 ? v1[ahi] + v2[bhi] : -3.0e38f;
        c[I] = f2key(hi ? shi : slo, hi ? hi_i : lo_i, 63);
        CandFill<I + 1>::run(c, v1, v2, hi);
    }
};
template <> struct CandFill<32> { static __device__ __forceinline__ void run(int (&)[32], const float (&)[16], const float (&)[16], bool) {} };

__device__ __forceinline__ void p7_topk(const Args& A, LAS unsigned char* lds, int layer, int nrows, int vcu, int G, int wave) {
    const int lane = fresh_lane(), tid = wave * 64 + lane, tok = lane & 31, hi = lane >> 5;
    const bf16_t* QP = (const bf16_t*)(A.ws + WS_QP);
    const bf16_t* K12 = (const bf16_t*)(A.ws + WS_K12) + (size_t)layer * 2 * 131072;
    int* EID = (int*)(A.ws + WS_EID); float* GWo = (float*)(A.ws + WS_GW);
    if (tid < 64) { int a = 0, b = 0, cnt = 0; for (int aa = 0; aa < 16; ++aa) for (int bb = 0; bb < 16; ++bb) if ((aa + 1) * (bb + 1) <= 16) { if (cnt == tid) { a = aa; b = bb; } ++cnt; }
        lds[LDS_TAB + 2 * tid] = (unsigned char)a; lds[LDS_TAB + 2 * tid + 1] = (unsigned char)b; }
    const int nunits = (nrows / 256) * 8;
    int staged_h = -1;
    bf16x8 bqA[8], bqB[8];
#define TOPK_LOADQ(DST, U, TW, HALF) do { const int h_ = (U) & 7, t0_ = ((U) >> 3) * 256 + (TW) * 32; const bf16_t* qrow_ = QP + (size_t)(t0_ + tok) * 2048 + h_ * 256 + (HALF) * 128 + 8 * hi; \
        _Pragma("unroll") for (int ks = 0; ks < 8; ++ks) DST[ks] = *(const bf16x8*)(qrow_ + 16 * ks); } while (0)
    const int R = nunits / G, tailn = nunits - R * G; const bool split = tailn > 0 && tailn * 4 == G && (tailn & 7) == 0;
    const int nit = R + (tailn > 0 ? 1 : 0);
#define TOPK_ITEM(IT, U, TW, ACT) const int U = (IT) < R ? vcu + (IT) * G : (split ? R * G + (vcu & (tailn - 1)) : vcu + R * G); \
        const int TW = ((IT) < R || !split) ? wave : 2 * (vcu / tailn) + wave; const bool ACT = (IT) < R ? true : (split ? wave < 2 : U < nunits)
    { TOPK_ITEM(0, u0, tw0, act0); if (nit > 0 && act0) TOPK_LOADQ(bqA, u0, tw0, 0); }
    for (int it = 0; it < nit; ++it) {
        TOPK_ITEM(it, u, tw, act);
        const int h = u & 7, tile = u >> 3;
        if (h != staged_h) {
            __syncthreads();
            for (int i = tid; i < 2 * 2048; i += NTHR) { const int which = i >> 11, c = i & 2047, row = c >> 4, ch = c & 15;
                const u32x4 v = *(const u32x4*)(K12 + (size_t)which * 131072 + (size_t)h * 16384 + row * 128 + ch * 8);
                *(LAS u32x4*)(lds + (which ? LDS_K2 : LDS_K1) + row * KROW + ch * 16) = v; }
            __syncthreads();
            staged_h = h;
        }
        if (!act) continue;
        const int t0 = tile * 256 + tw * 32;
        int L1[16], L2[16];
#pragma unroll
        for (int half = 0; half < 2; ++half) {
            if (half == 0) TOPK_LOADQ(bqB, u, tw, 1); else if (it + 1 < nit) { TOPK_ITEM(it + 1, un, twn, actn); if (actn) TOPK_LOADQ(bqA, un, twn, 0); }
            f32x16 acc[4];
#pragma unroll
            for (int kb = 0; kb < 4; ++kb) { acc[kb] = f32x16{};
                const LAS unsigned char* kp = lds + (half ? LDS_K2 : LDS_K1) + (kb * 32 + tok) * KROW + 16 * hi;
#pragma unroll
                for (int ks = 0; ks < 8; ++ks) { const bf16x8 a = *(const LAS bf16x8*)(kp + 32 * ks); acc[kb] = __builtin_amdgcn_mfma_f32_32x32x16_bf16(a, half ? bqB[ks] : bqA[ks], acc[kb], 0, 0, 0); } }
            int g0[16], g1[16], g2[16], g3[16];
#pragma unroll
            for (int r = 0; r < 16; ++r) { const int kr = (r & 3) + 8 * (r >> 2) + 4 * hi;
                g0[r] = f2key(acc[0][r], kr, 127); g1[r] = f2key(acc[1][r], 32 + kr, 127); g2[r] = f2key(acc[2][r], 64 + kr, 127); g3[r] = f2key(acc[3][r], 96 + kr, 127); }
            top16_of_64(g0, g1, g2, g3);
#pragma unroll
            for (int i = 0; i < 16; ++i) { if (half == 0) L1[i] = g0[i]; else L2[i] = g0[i]; }
        }
        int Wm[16], Wo[16];
#pragma unroll
        for (int i = 0; i < 16; ++i) { auto rr = __builtin_amdgcn_permlane32_swap((unsigned)L1[i], (unsigned)L2[i], false, false); Wm[i] = (int)rr[0]; Wo[i] = (int)rr[1]; }
        merge_top16(Wm, Wo);
        float v1[16], v2[16]; int i1[16], i2[16];
#pragma unroll
        for (int i = 0; i < 16; ++i) { auto rr = __builtin_amdgcn_permlane32_swap((unsigned)Wm[i], (unsigned)Wm[i], false, false);
            const int b1 = key2bits((int)rr[0]), b2 = key2bits((int)rr[1]); v1[i] = __int_as_float(b1); v2[i] = __int_as_float(b2); i1[i] = b1 & 127; i2[i] = b2 & 127; }
        { u32x4 w;
          w.x = (hi ? i2[0] : i1[0]) | ((hi ? i2[1] : i1[1]) << 8) | ((hi ? i2[2] : i1[2]) << 16) | ((hi ? i2[3] : i1[3]) << 24);
          w.y = (hi ? i2[4] : i1[4]) | ((hi ? i2[5] : i1[5]) << 8) | ((hi ? i2[6] : i1[6]) << 16) | ((hi ? i2[7] : i1[7]) << 24);
          w.z = (hi ? i2[8] : i1[8]) | ((hi ? i2[9] : i1[9]) << 8) | ((hi ? i2[10] : i1[10]) << 16) | ((hi ? i2[11] : i1[11]) << 24);
          w.w = (hi ? i2[12] : i1[12]) | ((hi ? i2[13] : i1[13]) << 8) | ((hi ? i2[14] : i1[14]) << 16) | ((hi ? i2[15] : i1[15]) << 24);
          *(LAS u32x4*)(lds + LDS_IDX + wave * 1024 + tok * 32 + hi * 16) = w; }
        int c[32];
        CandFill<0>::run(c, v1, v2, hi != 0);
        int ca[16], cb[16];
#pragma unroll
        for (int i = 0; i < 16; ++i) { ca[i] = c[i]; cb[i] = c[16 + i]; }
        sort16_desc(ca); sort16_desc(cb); merge_top16(ca, cb);
        int T[16];
#pragma unroll
        for (int i = 0; i < 16; ++i) { auto rr = __builtin_amdgcn_permlane32_swap((unsigned)ca[i], (unsigned)ca[i], false, false); T[i] = (int)rr[0]; cb[i] = (int)rr[1]; }
#pragma unroll
        for (int i = 0; i < 16; ++i) T[i] = kmax(T[i], cb[15 - i]);
        float sv[16]; float mx = -INFINITY;
#pragma unroll
        for (int i = 0; i < 16; ++i) { sv[i] = __int_as_float(key2bits(T[i])); mx = fmaxf(mx, sv[i]); }
        float sum = 0.f;
#pragma unroll
        for (int i = 0; i < 16; ++i) { sv[i] = __expf(sv[i] - mx); sum += sv[i]; }
        const float inv = 1.f / sum;
        LDS_WAIT(); asm volatile("" ::: "memory");
        int eo[8]; float go[8];
#pragma unroll
        for (int i = 0; i < 8; ++i) { const int kk = hi ? T[8 + i] : T[i]; const int li = key2bits(kk) & 63;
            const int a = lds[LDS_TAB + 2 * li], b = lds[LDS_TAB + 2 * li + 1];
            const int k1i = lds[LDS_IDX + wave * 1024 + tok * 32 + a], k2i = lds[LDS_IDX + wave * 1024 + tok * 32 + 16 + b];
            eo[i] = k1i * 128 + k2i; go[i] = (hi ? sv[8 + i] : sv[i]) * inv; }
        int* ep = EID + (size_t)(t0 + tok) * 128 + h * 16 + hi * 8; float* gp = GWo + (size_t)(t0 + tok) * 128 + h * 16 + hi * 8;
        { typedef int i32x4 __attribute__((ext_vector_type(4))); i32x4 e0v = {eo[0], eo[1], eo[2], eo[3]}, e1v = {eo[4], eo[5], eo[6], eo[7]}; *(i32x4*)ep = e0v; *(i32x4*)(ep + 4) = e1v;
          f32x4 g0v = {go[0], go[1], go[2], go[3]}, g1v = {go[4], go[5], go[6], go[7]}; *(f32x4*)gp = g0v; *(f32x4*)(gp + 4) = g1v; }
    }
#undef TOPK_LOADQ
#undef TOPK_ITEM
    __syncthreads();
}
}
using topk::p7_topk;
#undef MK_HAVE_P10
#define MK_HAVE_P10 1
namespace mls {
typedef short bf16x8 __attribute__((ext_vector_type(8)));
typedef float f32x16 __attribute__((ext_vector_type(16)));
constexpr int S272 = 272, S144 = 144;
constexpr int L_GB = 0, L_GBETA = 9216, L_GPM = 18432;
constexpr int L_Q = 27648, L_K = L_Q + 64 * S272, L_KWT = L_K + 64 * S272;
constexpr int L_VT = L_KWT + 128 * S144, L_SP = L_VT + 96 * S144;
constexpr int L_CB = L_SP + 64 * S144;
constexpr int L_NS = L_CB + 96 * S272, L_DEN = L_NS + 512, L_QN = L_DEN + 512, L_END = L_QN + 256;
static_assert(L_END <= RING_BYTES, "mlstm LDS map");
__device__ __forceinline__ int crow(int r, int hi) { return (r & 3) + 8 * (r >> 2) + 4 * hi; }
__device__ __forceinline__ float logsig(float x) { return fminf(x, 0.f) - log1pf(__expf(-fabsf(x))); }
template <int NK> __device__ __forceinline__ f32x16 mfma_chain(LAS unsigned char* lds, int aoff, int boff, f32x16 acc) {
    bf16x8 fa[NK], fb[NK];
#pragma unroll
    for (int ks = 0; ks < NK; ++ks) { fa[ks] = *(const LAS bf16x8*)(lds + aoff + 32 * ks); fb[ks] = *(const LAS bf16x8*)(lds + boff + 32 * ks); }
    __builtin_amdgcn_sched_barrier(0);
#pragma unroll
    for (int ks = 0; ks < NK; ++ks) acc = __builtin_amdgcn_mfma_f32_32x32x16_bf16(fa[ks], fb[ks], acc, 0, 0, 0);
    return acc;
}
#define LDS_BAR() do { if (ABL != 5) asm volatile("s_waitcnt lgkmcnt(0)\n\ts_barrier" ::: "memory"); } while (0)
#define EX2(x) __builtin_amdgcn_exp2f(x)
#define MFMA32(a, b, c) __builtin_amdgcn_mfma_f32_32x32x16_bf16(a, b, c, 0, 0, 0)
#define LDB8(off) (*(const LAS bf16x8*)(lds + (off)))

template <int ABL>
__device__ __forceinline__ void p10_mlstm_t(const Args& A, LAS unsigned char* lds, int vcu, int G, int wave) {
    const int lane = fresh_lane(), tid = wave * 64 + lane, r32 = lane & 31, hi = lane >> 5;
    const bf16_t* QM = (const bf16_t*)(A.ws + WS_QM); const bf16_t* KM = (const bf16_t*)(A.ws + WS_KM); const bf16_t* KT = (const bf16_t*)(A.ws + WS_KT); const bf16_t* VT = (const bf16_t*)(A.ws + WS_VM);
    const float* GT = (const float*)(A.ws + WS_GATE);
    for (int u = vcu; u < 256; u += G) {
        const int sl = u & 3, hd = (u >> 2) & 3, dir = (u >> 4) & 1, b = u >> 5;
        bf16_t* HO = (bf16_t*)(A.ws + (dir ? WS_YBF : WS_HBF));
        __syncthreads();
        for (int i = tid; i < (L_END - L_Q) / 4; i += NTHR) ((LAS unsigned*)(lds + L_Q))[i] = 0u;
        __syncthreads();
        if (tid < 32) ((LAS unsigned*)(lds + L_VT + 64 * S144))[tid] = 0x3F803F80u;
#define CHUNK(step) ((step) < 4 ? (TL + b * CTX) / 64 + (dir ? 3 - (step) : (step)) : (b * SEQ) / 64 + (dir ? 35 - (step) : (step) - 4))
        for (int step = wave; step < 36; step += NWAVES) {
            const int p = dir ? 63 - lane : lane;
            const size_t row = (size_t)CHUNK(step) * 64 + p;
            const float gi = GT[row * 16 + (dir * 2) * 4 + hd], gf = GT[row * 16 + (dir * 2 + 1) * 4 + hd];
            float bsum = logsig(gf) * 1.4426950408889634f;
#pragma unroll
            for (int o = 1; o < 64; o <<= 1) { const float t = __shfl_up(bsum, o); if (lane >= o) bsum += t; }
            const float beta = gi * 1.4426950408889634f - bsum; float pm = beta;
#pragma unroll
            for (int o = 1; o < 64; o <<= 1) { const float t = __shfl_up(pm, o); if (lane >= o) pm = fmaxf(pm, t); }
            ((LAS float*)(lds + L_GB))[step * 64 + p] = bsum; ((LAS float*)(lds + L_GBETA))[step * 64 + p] = beta; ((LAS float*)(lds + L_GPM))[step * 64 + p] = pm;
        }
        const int plast = dir ? 0 : 63;
        u32x4 rq[2][2], rk[2][2], rkt[2][2], rv[2];
#define LOADSTEP(step, P) do { const size_t cg_ = (size_t)CHUNK(step); \
            _Pragma("unroll") for (int i_ = 0; i_ < 2; ++i_) { const int c_ = tid + 512 * i_; const size_t row_ = cg_ * 64 + (c_ >> 4); \
                rq[P][i_] = *(const u32x4*)(QM + row_ * 512 + hd * 128 + (c_ & 15) * 8); rk[P][i_] = *(const u32x4*)(KM + row_ * 512 + hd * 128 + (c_ & 15) * 8); \
                rkt[P][i_] = *(const u32x4*)(KT + ((cg_ * 512 + hd * 128 + (c_ >> 3)) * 64) + (c_ & 7) * 8); } \
            rv[P] = *(const u32x4*)(VT + ((cg_ * 1024 + hd * 256 + sl * 64 + (tid >> 3)) * 64) + (tid & 7) * 8); } while (0)
        LOADSTEP(0, 0); LOADSTEP(1, 1);
        f32x16 accCn = f32x16{};
        f32x16 accC = f32x16{};
        float m = 0.f;
        __syncthreads();
        if (wave == 7) ((LAS float*)(lds + L_NS))[lane] = EX2(((const LAS float*)(lds + L_GBETA))[lane] - fmaxf(0.f, ((const LAS float*)(lds + L_GPM))[plast]));
        __syncthreads();
        for (int step2 = 0; step2 < 36; step2 += 2) {
#pragma unroll
          for (int par = 0; par < 2; ++par) {
            const int step = step2 + par;
            const LAS float* gb = (const LAS float*)(lds + L_GB) + step * 64; const LAS float* gbeta = (const LAS float*)(lds + L_GBETA) + step * 64; const LAS float* gpm = (const LAS float*)(lds + L_GPM) + step * 64;
            const float Mlast = fmaxf(m, gpm[plast]), dc = EX2(m - Mlast);
#pragma unroll
            for (int i = 0; i < 2; ++i) { const int c = tid + 512 * i;
                *(LAS u32x4*)(lds + L_Q + (c >> 4) * S272 + (c & 15) * 16) = rq[par][i]; *(LAS u32x4*)(lds + L_K + (c >> 4) * S272 + (c & 15) * 16) = rk[par][i];
                const int s0 = (c & 7) * 8; const f32x4 b0 = *(const LAS f32x4*)(lds + L_NS + 4 * s0), b1 = *(const LAS f32x4*)(lds + L_NS + 4 * s0 + 16);
                u32x4 o;
                if (ABL == 6) { o = rkt[par][i]; } else {
                o.x = pk2(bflo(rkt[par][i].x) * b0.x, bfhi(rkt[par][i].x) * b0.y); o.y = pk2(bflo(rkt[par][i].y) * b0.z, bfhi(rkt[par][i].y) * b0.w);
                o.z = pk2(bflo(rkt[par][i].z) * b1.x, bfhi(rkt[par][i].z) * b1.y); o.w = pk2(bflo(rkt[par][i].w) * b1.z, bfhi(rkt[par][i].w) * b1.w); }
                *(LAS u32x4*)(lds + L_KWT + (c >> 3) * S144 + (c & 7) * 16) = o; }
            *(LAS u32x4*)(lds + L_VT + (tid >> 3) * S144 + (tid & 7) * 16) = rv[par];
            if (ABL != 4) LOADSTEP((step + 2 < 36 ? step + 2 : 35), par);
            LDS_BAR();
            f32x16 accN = f32x16{};
            if (ABL == 7) { LDS_BAR(); LDS_BAR(); m = gb[plast] + Mlast; continue; }
            if (wave < 4) { if (ABL != 9) {
                const int vb = wave & 1, tb = wave >> 1;
accN = mfma_chain<8>(lds, L_CB + (vb * 32 + r32) * S272 + 16 * hi, L_Q + (tb * 32 + r32) * S272 + 16 * hi, accN);
                const float aw = EX2(m - fmaxf(m, gpm[tb * 32 + r32]));
#pragma unroll
                for (int r = 0; r < 16; ++r) accN[r] *= aw; }
            } else if (wave < 7) { if (ABL != 8) {
                const int sb = wave == 4 ? 0 : (wave == 6 ? 1 : dir), tb = wave == 4 ? 0 : (wave == 6 ? 1 : 1 - dir);
                f32x16 accS = f32x16{};
accS = mfma_chain<8>(lds, L_K + (sb * 32 + r32) * S272 + 16 * hi, L_Q + (tb * 32 + r32) * S272 + 16 * hi, accS);
                const int t = tb * 32 + r32; const float Mt = fmaxf(m, gpm[t]);
                float rs = 0.f;
#pragma unroll
                for (int g = 0; g < 4; ++g) { float pv[4];
#pragma unroll
                    for (int q = 0; q < 4; ++q) { const int s = sb * 32 + 8 * g + 4 * hi + q; const bool ok = (sb != tb) || (dir ? (s >= t) : (s <= t)); const float w = ABL == 3 ? 0.5f : (ok ? EX2(gbeta[s] - Mt) : 0.f); pv[q] = accS[4 * g + q] * w; rs += pv[q]; }
                    u32x2 o; o.x = pk2(pv[0], pv[1]); o.y = pk2(pv[2], pv[3]);
                    *(LAS u32x2*)(lds + L_SP + t * S144 + (sb * 32 + 8 * g + 4 * hi) * 2) = o; }
                rs += xshfl<32>(rs);
                if (hi == 0) ((LAS float*)(lds + L_DEN))[sb * 64 + t] = rs; }
            } else if (ABL != 1) {
#pragma unroll
                for (int tb = 0; tb < 2; ++tb) { f32x16 aq = f32x16{};
aq = mfma_chain<8>(lds, L_CB + (64 + r32) * S272 + 16 * hi, L_Q + (tb * 32 + r32) * S272 + 16 * hi, aq);
                    if (hi == 0) ((LAS float*)(lds + L_QN))[tb * 32 + r32] = aq[0]; }
            }
            { const int vb = wave & 1, db = wave >> 1;
#pragma unroll
              for (int r = 0; r < 16; ++r) accC[r] *= dc;
accC = mfma_chain<4>(lds, L_KWT + (db * 32 + r32) * S144 + 16 * hi, L_VT + (vb * 32 + r32) * S144 + 16 * hi, accC); }
            if (wave < 4) {
#pragma unroll
              for (int r = 0; r < 16; ++r) accCn[r] *= dc;
accCn = mfma_chain<4>(lds, L_KWT + (wave * 32 + r32) * S144 + 16 * hi, L_VT + (64 + r32) * S144 + 16 * hi, accCn); }
            LDS_BAR();
            if (wave < 4 && ABL != 10) {
                const int vb = wave & 1, tb = wave >> 1, t = tb * 32 + r32;
accN = mfma_chain<4>(lds, L_VT + (vb * 32 + r32) * S144 + 16 * hi, L_SP + (tb * 32 + r32) * S144 + 16 * hi, accN);
                if (step >= 4) {
                    const float Mt = fmaxf(m, gpm[t]), aw = EX2(m - Mt);
                    const float den = ((const LAS float*)(lds + L_DEN))[t] + ((const LAS float*)(lds + L_DEN))[64 + t] + aw * ((const LAS float*)(lds + L_QN))[t];
                    const float inv = 1.f / fmaxf(fabsf(den), EX2(-(gb[t] + Mt)));
                    bf16_t* hp = HO + ((size_t)CHUNK(step) * 64 + t) * D + hd * 256 + sl * 64 + vb * 32 + 4 * hi;
#pragma unroll
                    for (int g = 0; g < 4; ++g) { u32x2 o; o.x = pk2(accN[4 * g] * inv, accN[4 * g + 1] * inv); o.y = pk2(accN[4 * g + 2] * inv, accN[4 * g + 3] * inv); *(u32x2*)(hp + 8 * g) = o; }
                }
            }
            { const int vb = wave & 1, db = wave >> 1;
#pragma unroll
              for (int g = 0; g < 4; ++g) { u32x2 o; o.x = pk2(accC[4 * g], accC[4 * g + 1]); o.y = pk2(accC[4 * g + 2], accC[4 * g + 3]);
                  *(LAS u32x2*)(lds + L_CB + (vb * 32 + r32) * S272 + (db * 32 + 8 * g + 4 * hi) * 2) = o; } }
            if (wave < 4) {
#pragma unroll
              for (int g = 0; g < 4; ++g) { u32x2 o; o.x = pk2(accCn[4 * g], accCn[4 * g + 1]); o.y = pk2(accCn[4 * g + 2], accCn[4 * g + 3]);
                  *(LAS u32x2*)(lds + L_CB + (64 + r32) * S272 + (wave * 32 + 8 * g + 4 * hi) * 2) = o; } }
            m = gb[plast] + Mlast;
            if (wave == 7 && step + 1 < 36) {
                const float Mn = fmaxf(m, ((const LAS float*)(lds + L_GPM))[(step + 1) * 64 + plast]);
                ((LAS float*)(lds + L_NS))[lane] = EX2(((const LAS float*)(lds + L_GBETA))[(step + 1) * 64 + lane] - Mn); }
            LDS_BAR();
          }
        }
#undef LOADSTEP
#undef CHUNK
    }
    __syncthreads();
}
#undef EX2
#undef MFMA32
#undef LDB8

__device__ __forceinline__ void p11_finish(const Args& A, int gw, int NGW, int lane) {
    const bf16_t* HF = (const bf16_t*)(A.ws + WS_HBF); bf16_t* HB = (bf16_t*)(A.ws + WS_YBF); const bf16_t* OM = (const bf16_t*)(A.ws + WS_OM); const float* ng = SMF(A.ws, SM_MLNG);
    u32x2 na[4], nc[4], no[4]; f32x4 g[4];
#pragma unroll
    for (int j = 0; j < 4; ++j) g[j] = *(const f32x4*)(ng + 256 * j + lane * 4);
    if (gw < TL) { const size_t base = (size_t)gw * D + lane * 4;
#pragma unroll
        for (int j = 0; j < 4; ++j) { na[j] = *(const u32x2*)(HF + base + 256 * j); nc[j] = *(const u32x2*)(HB + base + 256 * j); no[j] = *(const u32x2*)(OM + base + 256 * j); } }
    for (int r = gw; r < TL; r += NGW) {
        const size_t base = (size_t)r * D + lane * 4;
        u32x2 a[4], c[4], o[4];
#pragma unroll
        for (int j = 0; j < 4; ++j) { a[j] = na[j]; c[j] = nc[j]; o[j] = no[j]; }
        { int lq = lane; asm volatile("" : "+v"(lq));
          const size_t nb = (size_t)(r + NGW < TL ? r + NGW : r) * D + lq * 4;
#pragma unroll
          for (int j = 0; j < 4; ++j) { na[j] = *(const u32x2*)(HF + nb + 256 * j); nc[j] = *(const u32x2*)(HB + nb + 256 * j); no[j] = *(const u32x2*)(OM + nb + 256 * j); } }
        __builtin_amdgcn_sched_barrier(0);
        float v[4][4], mu[4], rs[4];
#pragma unroll
        for (int j = 0; j < 4; ++j) { v[j][0] = bflo(a[j].x) + bflo(c[j].x); v[j][1] = bfhi(a[j].x) + bfhi(c[j].x); v[j][2] = bflo(a[j].y) + bflo(c[j].y); v[j][3] = bfhi(a[j].y) + bfhi(c[j].y); mu[j] = (v[j][0] + v[j][1]) + (v[j][2] + v[j][3]); }
#pragma unroll
        for (int j = 0; j < 4; ++j) mu[j] = wsum(mu[j]) * (1.f / 256.f);
#pragma unroll
        for (int j = 0; j < 4; ++j) {
#pragma unroll
            for (int i = 0; i < 4; ++i) v[j][i] -= mu[j];
            rs[j] = (v[j][0] * v[j][0] + v[j][1] * v[j][1]) + (v[j][2] * v[j][2] + v[j][3] * v[j][3]); }
#pragma unroll
        for (int j = 0; j < 4; ++j) rs[j] = rsqrtf(wsum(rs[j]) * (1.f / 256.f) + EPS);
#pragma unroll
        for (int j = 0; j < 4; ++j) {
            u32x2 w; w.x = pk2(v[j][0] * rs[j] * g[j].x * sigmoidf_(bflo(o[j].x)), v[j][1] * rs[j] * g[j].y * sigmoidf_(bfhi(o[j].x))); w.y = pk2(v[j][2] * rs[j] * g[j].z * sigmoidf_(bflo(o[j].y)), v[j][3] * rs[j] * g[j].w * sigmoidf_(bfhi(o[j].y)));
            *(u32x2*)(HB + base + 256 * j) = w; }
    }
}
}
__device__ __forceinline__ void p10_mlstm(const Args& A, LAS unsigned char* lds, int vcu, int G, int wave) { mls::p10_mlstm_t<0>(A, lds, vcu, G, wave); }
using mls::p11_finish;
#ifndef MK_HAVE_P3
#define MK_HAVE_P3 0
#endif
#ifndef MK_HAVE_P7
#define MK_HAVE_P7 0
#endif
#ifndef MK_HAVE_P10
#define MK_HAVE_P10 0
#endif
#ifndef MK_ALL
#define MK_ALL 0
#endif
constexpr int NPHASE = 17;
__device__ __forceinline__ int opaque_s(int x) { x = __builtin_amdgcn_readfirstlane(x); asm volatile("" : "+s"(x)); return x; }
#if MK_ALL
#define IN(k) true
#else
#define IN(k) (A.ph_lo <= (k) && (k) < A.ph_hi)
#endif
#define SEAM(k) do { if (IN(k) && IN((k) + 1)) xcd_barrier(bar, WV()); } while (0)
#define WV() opaque_s(wave)
#define TID() (WV() * 64 + fresh_lane())
template <int L>
__device__ __forceinline__ void layer_phases(const Args& A, LAS unsigned char* lds, unsigned char* lds_raw, const XcdBarrier& bar, const int wave, const int vcu, const int gw, const int NGW, const int G, const int bx) {
    unsigned char* ws = A.ws;
    bf16_t* HBF = (bf16_t*)(ws + WS_HBF); bf16_t* YBF = (bf16_t*)(ws + WS_YBF);
    float* XC = (float*)(ws + WS_XC); float* XL = A.out;
    const float* MOD0 = (const float*)(ws + WS_MOD);
    constexpr int nrows = L ? TL : TT;
    if constexpr (L == 0) {
        if (IN(2)) {
            pg8::Gemm g{HBF, (const bf16_t*)(ws + WS_WIN0), TT, AB_IN, D}; pg8::StaticOrder S; S.init(TT, AB_IN, G, opaque_s(bx));
            epi::EpiIn0 E{(bf16_t*)(ws + WS_GLU), (bf16_t*)(ws + WS_Q), (bf16_t*)(ws + WS_K), (bf16_t*)(ws + WS_V), (const float*)(ws + WS_MISC), SMF(ws, SM_QNG), SMF(ws, SM_KNG),
                          (const float*)(ws + WS_MISC + 8192), (const float*)(ws + WS_MISC + 12288)};
            pg8::gemm_phase<epi::EpiIn0, pg8::StaticOrder, true, true>(lds, g, S, E, WV());
        }
        SEAM(2);
#if MK_HAVE_P3
        if (IN(3)) p3_attn_conv(A, lds_raw, opaque_s(vcu), G, WV());
#endif
        SEAM(3);
    } else {
        if (IN(9)) {
            pg8::Gemm g{HBF, (const bf16_t*)(ws + WS_WIN1), TT, 3072, D}; pg8::StaticOrder S; S.init(TT, 3072, G, opaque_s(bx));
            epi::EpiIn1 E{(bf16_t*)(ws + WS_QM), (bf16_t*)(ws + WS_KM), (bf16_t*)(ws + WS_KT), (bf16_t*)(ws + WS_VM), (bf16_t*)(ws + WS_OM), SMF(ws, SM_MLBIN)};
            pg8::gemm_phase<epi::EpiIn1, pg8::StaticOrder, true, true>(lds, g, S, E, WV());
#ifdef DEFER_TABLES
            {
                const int rem = ((TT / 256) * (3072 / 256)) % G, nid = rem ? G - rem : G, c = opaque_s(bx);
                if (c >= rem) { p0_weight1(A.in[I_MLWOUT], D, 32, (bf16_t*)(ws + WS_WOUT1), P0W_SQ, (LAS float*)(lds + WV() * 16384), (c - rem) * NWAVES + WV(), nid * NWAVES, fresh_lane());
                                p0_weight1(A.in[I_PWQ] + (size_t)D * 2048, 2048, 64, (bf16_t*)(ws + WS_WQ1), P0W_WQ, (LAS float*)(lds + WV() * 16384), (c - rem) * NWAVES + WV(), nid * NWAVES, fresh_lane());
                                p0_tables(A, DEFER_Q2, 32768, (c - rem) * NWAVES + WV(), nid * NWAVES, fresh_lane()); }
            }
#endif
        }
        SEAM(9);
#if MK_HAVE_P10
        if (IN(10)) p10_mlstm(A, lds, opaque_s(vcu), G, WV());
        SEAM(10);
        if (IN(11)) p11_finish(A, opaque_s(gw), NGW, fresh_lane());
#else
        SEAM(10);
#endif
        SEAM(11);
    }
    constexpr int pb = L ? 12 : 4;
    if (IN(pb)) {
        pg8::Gemm g{YBF, (const bf16_t*)(ws + (L ? WS_WOUT1 : WS_WOUT0)), nrows, D, D}; pg8::StaticOrder S; S.init(nrows, D, G, opaque_s(bx));
        epi::EpiResid E{A.in[I_X], A.in[I_CTX], L ? (const bf16_t*)(ws + WS_XS) : (const bf16_t*)nullptr, (bf16_t*)(ws + WS_XB), MOD0 + (size_t)L * 9 * NMOD + 2 * D, L ? SMF(ws, SM_MLBOUT) : SMF(ws, SM_ABBOUT)};
        pg8::gemm_phase<epi::EpiResid, pg8::StaticOrder, true, true>(lds, g, S, E, WV());
#ifdef DEFER_TABLES
        if constexpr (L == 0) {
            const int rem = ((nrows / 256) * (D / 256)) % G, nid = rem ? G - rem : G, c = opaque_s(bx);
            if (c >= rem) { p0_weight1(A.in[I_PWQ], 2048, 64, (bf16_t*)(ws + WS_WQ0), P0W_WQ, (LAS float*)(lds + WV() * 16384), (c - rem) * NWAVES + WV(), nid * NWAVES, fresh_lane());
                            p0_tables(A, 0, DEFER_Q1, (c - rem) * NWAVES + WV(), nid * NWAVES, fresh_lane()); }
        }
#endif
    }
    SEAM(pb);
    if (IN(pb + 1)) p5_ln_ln_mod(A, L, nrows, opaque_s(gw), NGW, fresh_lane());
    SEAM(pb + 1);
    if (IN(pb + 2)) {
        pg8::Gemm g{HBF, (const bf16_t*)(ws + (L ? WS_WQ1 : WS_WQ0)), nrows, 2048, D}; pg8::StaticOrder S; S.init(nrows, 2048, G, opaque_s(bx));
        epi::EpiPlain E{(bf16_t*)(ws + WS_QP), 2048};
        pg8::gemm_phase<epi::EpiPlain, pg8::StaticOrder, true, true>(lds, g, S, E, WV());
#ifdef DEFER_TABLES
        if constexpr (L == 0) {
            const int rem = ((nrows / 256) * (2048 / 256)) % G, nid = rem ? G - rem : G, c = opaque_s(bx);
            if (c >= rem) { p0_weight1(A.in[I_MLWIN], C_IN, 96, (bf16_t*)(ws + WS_WIN1), P0W_IN1, (LAS float*)(lds + WV() * 16384), (c - rem) * NWAVES + WV(), nid * NWAVES, fresh_lane());
                            p0_tables(A, DEFER_Q1, DEFER_Q2, (c - rem) * NWAVES + WV(), nid * NWAVES, fresh_lane()); }
        }
#endif
    }
    SEAM(pb + 2);
#if MK_HAVE_P7
    if (IN(pb + 3)) p7_topk(A, lds, L, nrows, opaque_s(vcu), G, WV());
#endif
    SEAM(pb + 3);
    if (IN(pb + 4)) peer_apply_phase(A, lds, WV(), L, nrows, L == 1, opaque_s(gw), NGW, fresh_lane());
    if constexpr (L == 0) SEAM(8);
}
__global__ void __launch_bounds__(NTHR, 2) mk_fwd(Args A) {
    extern __shared__ __attribute__((aligned(16))) unsigned char lds_raw[];
    LAS unsigned char* lds = (LAS unsigned char*)lds_raw;
    const int wave = __builtin_amdgcn_readfirstlane(threadIdx.x >> 6);
    const int G = gridDim.x, bx = blockIdx.x;
    const int vcu = (G % 8 == 0) ? (bx % 8) * (G / 8) + bx / 8 : bx;
    const int gw = vcu * NWAVES + wave, NGW = G * NWAVES;
    { const int t0 = wave * 64 + fresh_lane(); for (int u = t0; u < (LDS_BYTES - LDSCTL_OFF) / 4; u += NTHR) ((LAS unsigned*)(lds + LDSCTL_OFF))[u] = 0u; }
    __syncthreads();
    XcdBarrier bar = xcd_barrier_post((unsigned*)(A.ws + WS_CTL) + CW_BAR, (volatile LAS unsigned*)(lds + MISC_OFF) + 8, wave);
    if (IN(0)) p0_prologue(A, lds, opaque_s(vcu), G, TID());
    SEAM(0);
    if (IN(1)) p1_ln_mod(A, opaque_s(gw), NGW, fresh_lane());
    SEAM(1);
    layer_phases<0>(A, lds, lds_raw, bar, wave, vcu, gw, NGW, G, bx);
    layer_phases<1>(A, lds, lds_raw, bar, wave, vcu, gw, NGW, G, bx);
#ifdef PROBE_ABLP
    if (IN(24)) peer_apply_phase_t<PROBE_ABLP>(A, lds, WV(), 0, TT, true, opaque_s(gw), NGW, fresh_lane());
    if (IN(22)) peer_apply_phase_t<PROBE_ABLP>(A, lds, WV(), 1, TL, true, opaque_s(gw), NGW, fresh_lane());
#endif
#ifdef PROBE_ABL3
    if (IN(21)) p3_attn_conv_t<PROBE_ABL3>(A, lds_raw, opaque_s(vcu), G, WV());
#endif
#ifdef PROBE_ABL
    if (IN(20)) mls::p10_mlstm_t<PROBE_ABL>(A, lds, opaque_s(vcu), G, WV());
#endif
}
#undef IN
#undef SEAM
#undef TID
#undef WV

static int g_grid = 0;
static void mk_launch(const Args& base, int lo, int hi, hipStream_t stream) {
    Args a = base; a.ph_lo = lo; a.ph_hi = hi;
    (void)hipMemsetAsync(a.ws + WS_CTL, 0, CTL_ZERO_BYTES, stream);
    void* params[] = {&a};
#ifdef PLAIN_LAUNCH
    hipError_t e = hipLaunchKernel((const void*)mk_fwd, dim3(g_grid), dim3(NTHR), params, LDS_BYTES, stream);
#else
    hipError_t e = hipLaunchCooperativeKernel((const void*)mk_fwd, dim3(g_grid), dim3(NTHR), params, LDS_BYTES, stream);
#endif
    if (e != hipSuccess) fprintf(stderr, "mk_launch [%d,%d): cooperative launch failed: %s (grid %d)\n", lo, hi, hipGetErrorString(e), g_grid);
}

#ifndef MK_A
#define MK_A 1
#endif
#ifndef MK_B
#define MK_B 0
#endif
#ifndef MK_C
#define MK_C 1
#endif
#ifndef MK_D
#define MK_D 0
#endif
#ifndef MK_E
#define MK_E 1
#endif
#ifndef MK_F
#define MK_F 1
#endif
#ifndef MK_G
#define MK_G 0
#endif
#ifndef MK_H
#define MK_H 1
#endif
#ifndef MK_I
#define MK_I 0
#endif
#ifndef MK_J
#define MK_J 1
#endif

extern "C" void kernel_launch(void* const* d_in, const int* in_sizes, int n_in, void* d_out, int out_size, void* d_ws, size_t ws_size, hipStream_t stream) {
    if (n_in != 30 || ws_size < WS_END2 || out_size != TL * D) { fprintf(stderr, "kernel_launch: unexpected n_in %d / ws %zu / out %d\n", n_in, ws_size, out_size); return; }
    if (g_grid == 0) {
        int dev = 0, cus = 0, per_cu = 0;
        (void)hipGetDevice(&dev); (void)hipDeviceGetAttribute(&cus, hipDeviceAttributeMultiprocessorCount, dev);
        (void)hipFuncSetAttribute((const void*)mk_fwd, hipFuncAttributeMaxDynamicSharedMemorySize, LDS_BYTES);
        (void)hipOccupancyMaxActiveBlocksPerMultiprocessor(&per_cu, (const void*)mk_fwd, NTHR, LDS_BYTES);
        if (per_cu < 1) { fprintf(stderr, "kernel_launch: occupancy query says %d blocks/CU\n", per_cu); per_cu = 1; }
        g_grid = cus;
        fprintf(stderr, "kernel_launch: cus %d per_cu %d grid %d\n", cus, per_cu, g_grid);
    }
    Args base{};
    for (int i = 0; i < 30; ++i) base.in[i] = (const float*)d_in[i];
    base.out = (float*)d_out; base.ws = (unsigned char*)d_ws;
#if MK_ALL
    mk_launch(base, 0, NPHASE, stream);
    return;
#endif
#ifdef PROBE_PH
    mk_launch(base, 0, NPHASE, stream);
    { Args dry = base; dry.out = (float*)((unsigned char*)d_ws + WS_C);
      for (int i = 0; i < PROBE_N; ++i) mk_launch(dry, PROBE_PH, PROBE_PH + 1, stream); }
    return;
#endif
#ifdef WITH_NAIVE
    const float* x = base.in[I_X]; const float* c = base.in[I_C]; const float* ctx = base.in[I_CTX]; const float* c_ctx = base.in[I_CCTX];
    const float* w_mod = base.in[I_WMOD]; const float* b_mod = base.in[I_BMOD];
    const float* ln1_g = base.in[I_LN1G]; const float* ln1_b = base.in[I_LN1B]; const float* ln2_g = base.in[I_LN2G]; const float* ln2_b = base.in[I_LN2B];
    const float* ab_w_in = base.in[I_ABWIN]; const float* ab_b_in = base.in[I_ABBIN]; const float* ab_conv_w = base.in[I_CONVW]; const float* ab_conv_b = base.in[I_CONVB];
    const float* ab_conv_ln_g = base.in[I_CLNG]; const float* ab_conv_ln_b = base.in[I_CLNB]; const float* ab_q_norm_g = base.in[I_QNG]; const float* ab_k_norm_g = base.in[I_KNG];
    const float* ab_w_out = base.in[I_ABWOUT]; const float* ab_b_out = base.in[I_ABBOUT];
    const float* ml_w_in = base.in[I_MLWIN]; const float* ml_b_in = base.in[I_MLBIN]; const float* ml_norm_g = base.in[I_MLNG]; const float* ml_w_out = base.in[I_MLWOUT]; const float* ml_b_out = base.in[I_MLBOUT];
    const float* peer_w_q = base.in[I_PWQ]; const float* peer_k1 = base.in[I_PK1]; const float* peer_k2 = base.in[I_PK2]; const float* peer_u = base.in[I_PU]; const float* peer_v = base.in[I_PV];
    char* ws = (char*)d_ws;
    float* MOD = (float*)(ws + WS_MOD); float* GATE = (float*)(ws + WS_GATE); float* XC = (float*)(ws + WS_XC);
    bf16_t* HBF = (bf16_t*)(ws + WS_HBF); bf16_t* YBF = (bf16_t*)(ws + WS_YBF); int* EID = (int*)(ws + WS_EID); float* GW = (float*)(ws + WS_GW);
    bf16_t* GLU = (bf16_t*)(ws + WS_GLU); bf16_t* Qb = (bf16_t*)(ws + WS_Q); bf16_t* Kb = (bf16_t*)(ws + WS_K); bf16_t* Vb = (bf16_t*)(ws + WS_V);
    bf16_t* QM = (bf16_t*)(ws + WS_QM); bf16_t* KM = (bf16_t*)(ws + WS_KM); bf16_t* VM = (bf16_t*)(ws + WS_VM); bf16_t* OM = (bf16_t*)(ws + WS_OM);
    bf16_t* QP = (bf16_t*)(ws + WS_QP); bf16_t* NP = (bf16_t*)(ws + WS_NP);
    float* XL = (float*)d_out;
    const float* mod0 = MOD; const float* mod1 = MOD + 9 * NMOD;
#if MK_A
    mk_launch(base, 0, 1, stream); mk_launch(base, 1, 2, stream); mk_launch(base, 2, 3, stream);
#else
    mk_launch(base, 0, 1, stream);
    nk_mod<<<dim3(NMOD / 256, 9, 2), 256, 0, stream>>>(c, c_ctx, w_mod, b_mod, MOD);
    nk_ln_mod<<<TT, 256, 0, stream>>>(x, ctx, mod0, 0, D, HBF);
    nk_gemm<<<dim3(1024 / 64, TT / 64), 256, 0, stream>>>(HBF, ab_w_in, AB_IN, 0, 1024, ab_b_in, 1.f, NP);
    nk_glu<<<TT * 512 / 256, 256, 0, stream>>>(NP, GLU);
    nk_gemm<<<dim3(768 / 64, TT / 64), 256, 0, stream>>>(HBF, ab_w_in, AB_IN, 1024, 768, ab_b_in, 1.f, NP);
    nk_qkv<<<TT * 12 / 4, 256, 0, stream>>>(NP, ab_q_norm_g, ab_k_norm_g, Qb, Kb, Vb);
#endif
#if MK_B
    mk_launch(base, 3, 4, stream);
#else
    nk_attn<<<TT * 8 / 4, 256, 0, stream>>>(Qb, Kb, Vb, YBF);
    nk_conv<<<TT, 256, 0, stream>>>(GLU, ab_conv_w, ab_conv_b, ab_conv_ln_g, ab_conv_ln_b, YBF);
#endif
#if MK_C
    mk_launch(base, 4, 5, stream); mk_launch(base, 5, 6, stream); mk_launch(base, 6, 7, stream);
#else
    nk_gemm<<<dim3(1024 / 64, TT / 64), 256, 0, stream>>>(YBF, ab_w_out, D, 0, 1024, ab_b_out, 1.f, NP);
    nk_resid_ln<<<TT, 256, 0, stream>>>(x, ctx, XL, XC, NP, mod0, 2 * D, ln1_g, ln1_b);
    nk_ln_mod<<<TT, 256, 0, stream>>>(XL, XC, mod0, 3 * D, 4 * D, HBF);
    nk_gemm<<<dim3(2048 / 64, TT / 64), 256, 0, stream>>>(HBF, peer_w_q, 2048, 0, 2048, nullptr, 1.f, QP);
#endif
#if MK_D
    mk_launch(base, 7, 8, stream);
#else
    nk_peer_topk<<<TT, 256, 0, stream>>>(QP, peer_k1, peer_k2, EID, GW);
#endif
#if MK_E
    mk_launch(base, 8, 9, stream);
#else
    nk_peer_apply<<<TT, 256, 0, stream>>>(HBF, EID, GW, peer_u, peer_v, NP);
    nk_resid_ln<<<TT, 256, 0, stream>>>(XL, XC, XL, XC, NP, mod0, 5 * D, ln2_g, ln2_b);
    nk_ln_mod<<<TT, 256, 0, stream>>>(XL, XC, mod1, 0, D, HBF);
    nk_gates<<<TT / 4, 256, 0, stream>>>(HBF, ml_w_in, ml_b_in, GATE);
#endif
#if MK_F
    mk_launch(base, 9, 10, stream);
#else
    nk_gemm<<<dim3(512 / 64, TT / 64), 256, 0, stream>>>(HBF, ml_w_in, C_IN, 0, 512, ml_b_in, 1.f, QM);
    nk_gemm<<<dim3(512 / 64, TT / 64), 256, 0, stream>>>(HBF, ml_w_in, C_IN, 512, 512, ml_b_in, 0.08838834764831845f, KM);
    nk_gemm<<<dim3(1024 / 64, TT / 64), 256, 0, stream>>>(HBF, ml_w_in, C_IN, 1024, 1024, ml_b_in, 1.f, VM);
    nk_gemm<<<dim3(1024 / 64, TL / 64), 256, 0, stream>>>(HBF, ml_w_in, C_IN, 2048, 1024, ml_b_in, 1.f, OM);
#endif
#if MK_G
    mk_launch(base, 10, 11, stream); mk_launch(base, 11, 12, stream);
#else
    nk_mlstm<<<dim3(4, 4, NB * 2), 256, 0, stream>>>(QM, KM, VM, GATE, HBF, YBF);
    nk_ml_finish<<<TL, 256, 0, stream>>>(HBF, YBF, OM, ml_norm_g, YBF);
#endif
#if MK_H
    mk_launch(base, 12, 13, stream); mk_launch(base, 13, 14, stream); mk_launch(base, 14, 15, stream);
#else
    nk_gemm<<<dim3(1024 / 64, TL / 64), 256, 0, stream>>>(YBF, ml_w_out, D, 0, 1024, ml_b_out, 1.f, NP);
    nk_resid_ln<<<TL, 256, 0, stream>>>(XL, XC, XL, XC, NP, mod1, 2 * D, ln1_g + D, ln1_b + D);
    nk_ln_mod<<<TL, 256, 0, stream>>>(XL, XC, mod1, 3 * D, 4 * D, HBF);
    nk_gemm<<<dim3(2048 / 64, TL / 64), 256, 0, stream>>>(HBF, peer_w_q + (size_t)D * 2048, 2048, 0, 2048, nullptr, 1.f, QP);
#endif
#if MK_I
    mk_launch(base, 15, 16, stream);
#else
    nk_peer_topk<<<TL, 256, 0, stream>>>(QP, peer_k1 + 8 * 128 * 128, peer_k2 + 8 * 128 * 128, EID, GW);
#endif
#if MK_J
    mk_launch(base, 16, 17, stream);
#else
    nk_peer_apply<<<TL, 256, 0, stream>>>(HBF, EID, GW, peer_u + (size_t)16384 * D, peer_v + (size_t)16384 * D, NP);
    nk_resid_ln<<<TL, 256, 0, stream>>>(XL, XC, XL, XC, NP, mod1, 5 * D, ln2_g + D, ln2_b + D);
#endif
    (void)c; (void)c_ctx; (void)w_mod; (void)b_mod; (void)ab_w_in; (void)ab_b_in; (void)ab_q_norm_g; (void)ab_k_norm_g; (void)ab_w_out; (void)ab_b_out; (void)ml_w_in; (void)ml_b_in; (void)ml_w_out; (void)ml_b_out;
    (void)peer_w_q; (void)peer_u; (void)peer_v; (void)ln1_g; (void)ln1_b; (void)ln2_g; (void)ln2_b; (void)mod1; (void)NP; (void)GATE; (void)QM; (void)KM; (void)VM; (void)OM; (void)x; (void)ctx; (void)XC; (void)XL; (void)mod0;
    (void)GLU; (void)Qb; (void)Kb; (void)Vb; (void)EID; (void)GW; (void)QP; (void)HBF; (void)YBF; (void)ab_conv_w; (void)ab_conv_b; (void)ab_conv_ln_g; (void)ab_conv_ln_b; (void)ml_norm_g; (void)peer_k1; (void)peer_k2;
#endif
}
```
